# Optimizing an MI355X kernel written in HIP

```python
import jax, jax.numpy as jnp
from jax import lax
import numpy as np

D_MODEL = 2048
BATCH = 4
SEQ = 4096
DEPTH = 1

CHUNK = 64
D_MIX = D_MODEL
CONV_WIDTH = D_MIX // 2
CONV_GROUPS = 8
CONV_KERNEL = 31
DN_HEADS = 8
DN_HEAD_DIM = (D_MIX - CONV_WIDTH) // DN_HEADS
DN_WIDTH = DN_HEADS * DN_HEAD_DIM
SHORT_CONV = 4
D_FF = ((8 * D_MODEL // 3 + 255) // 256) * 256
N_MOD = 9
EPS = 1e-6
IN_SPLITS = [CONV_WIDTH, CONV_WIDTH, DN_WIDTH, DN_WIDTH, DN_WIDTH, DN_WIDTH, DN_HEADS, DN_HEADS]
IN_COLS = sum(IN_SPLITS)

kernel_name = "hybrid_conv_gdn_macaron_adaln"


def rmsnorm(x, w):
    xf = x.astype(jnp.float32)
    y = xf * lax.rsqrt(jnp.mean(xf * xf, axis=-1, keepdims=True) + EPS)
    return (y * w.astype(jnp.float32)).astype(x.dtype)


def modulate(h, shift, scale):
    return h * (1 + scale[:, None, :]) + shift[:, None, :]


def swiglu(h, wg, wu, wd):
    return (jax.nn.silu(h @ wg) * (h @ wu)) @ wd


def causal_dwconv(x, w):
    k = w.shape[0]
    return lax.conv_general_dilated(
        x, w[:, None, :].astype(x.dtype), window_strides=(1,), padding=[(k - 1, 0)],
        dimension_numbers=("NWC", "WIO", "NWC"), feature_group_count=x.shape[-1])


def l2norm(t):
    return t * lax.rsqrt(jnp.sum(t * t, axis=-1, keepdims=True) + EPS)


def conformer_conv_group(a, gate, w_dw, b_dw, ln_w, ln_b):
    h = a * jax.nn.sigmoid(gate)
    h = causal_dwconv(h, w_dw) + b_dw.astype(h.dtype)
    hf = h.astype(jnp.float32)
    mu = jnp.mean(hf, axis=-1, keepdims=True)
    var = jnp.mean(jnp.square(hf - mu), axis=-1, keepdims=True)
    hf = (hf - mu) * lax.rsqrt(var + EPS) * ln_w.astype(jnp.float32) + ln_b.astype(jnp.float32)
    return jax.nn.silu(hf).astype(a.dtype)


def gated_deltanet_group(q, k, v, z, b_raw, a_raw, w_short, a_log, dt_bias, onorm_w):
    B, S, _ = q.shape
    H, Dh, C = DN_HEADS, DN_HEAD_DIM, CHUNK
    N = S // C
    f32 = jnp.float32
    qkv = jax.nn.silu(causal_dwconv(jnp.concatenate([q, k, v], axis=-1), w_short))
    q, k, v = jnp.split(qkv.astype(f32), 3, axis=-1)

    def heads(t):
        return t.reshape(B, N, C, H, Dh).transpose(0, 3, 1, 2, 4)

    def hc(t):
        return t.reshape(B, N, C, H).transpose(0, 3, 1, 2)

    q = l2norm(heads(q)) * (Dh ** -0.5)
    k = l2norm(heads(k))
    v = heads(v)
    beta = hc(jax.nn.sigmoid(b_raw.astype(f32)))
    g = hc(-jnp.exp(a_log.astype(f32)) * jax.nn.softplus(a_raw.astype(f32) + dt_bias.astype(f32)))
    G = jnp.cumsum(g, axis=-1)

    idx = jnp.arange(C)
    tril = idx[:, None] >= idx[None, :]
    strict = idx[:, None] > idx[None, :]
    decay = jnp.exp(jnp.where(tril, G[..., :, None] - G[..., None, :], -jnp.inf))

    kb = k * beta[..., None]
    L = jnp.einsum("bhncd,bhnsd->bhncs", kb, k) * jnp.where(strict, decay, 0.0)
    rhs = jnp.concatenate([v * beta[..., None], kb * jnp.exp(G)[..., None]], axis=-1)
    sol = lax.linalg.triangular_solve(L + jnp.eye(C, dtype=f32), rhs, left_side=True,
                                      lower=True, unit_diagonal=True)
    u, w = jnp.split(sol, 2, axis=-1)
    a_intra = jnp.einsum("bhncd,bhnsd->bhncs", q, k) * decay

    def step(state, xs):
        q_n, k_n, u_n, w_n, a_n, g_n = xs
        v_new = u_n - jnp.einsum("bhcd,bhde->bhce", w_n, state)
        o = (jnp.einsum("bhcd,bhde->bhce", q_n * jnp.exp(g_n)[..., None], state)
             + jnp.einsum("bhcs,bhse->bhce", a_n, v_new))
        g_last = g_n[..., -1]
        state = (state * jnp.exp(g_last)[..., None, None]
                 + jnp.einsum("bhcd,bhce->bhde", k_n * jnp.exp(g_last[..., None] - g_n)[..., None], v_new))
        return state, o

    xs = tuple(jnp.moveaxis(t, 2, 0) for t in (q, k, u, w, a_intra, G))
    state0 = jnp.zeros((B, H, Dh, Dh), f32)
    _, o = lax.scan(step, state0, xs)
    o = o.transpose(1, 0, 3, 2, 4).reshape(B, S, H, Dh)
    o = o * lax.rsqrt(jnp.mean(o * o, axis=-1, keepdims=True) + EPS) * onorm_w.astype(f32)
    o = o * jax.nn.silu(z.astype(f32).reshape(B, S, H, Dh))
    return o.reshape(B, S, DN_WIDTH).astype(z.dtype)


def setup_inputs(seed: int = 0) -> dict:
    key = jax.random.key(seed)
    ks = jax.random.split(key, 32)
    f32 = jnp.float32
    nrm = lambda k, shape, s: jax.random.normal(k, shape, f32) * s
    D, L = D_MODEL, DEPTH
    dt = jnp.exp(jax.random.uniform(ks[16], (L, DN_HEADS), f32, np.log(1e-3), np.log(1e-1)))
    return {
        "x": nrm(ks[0], (BATCH, SEQ, D), 1.0),
        "c": nrm(ks[1], (BATCH, D), 1.0),
        "w_ada": nrm(ks[2], (L, D, N_MOD * D), D ** -0.5),
        "b_ada": nrm(ks[3], (L, N_MOD * D), 0.01),
        "ffn1_norm": 1.0 + nrm(ks[4], (L, D), 0.01),
        "ffn1_wg": nrm(ks[5], (L, D, D_FF), D ** -0.5),
        "ffn1_wu": nrm(ks[6], (L, D, D_FF), D ** -0.5),
        "ffn1_wd": nrm(ks[7], (L, D_FF, D), D_FF ** -0.5),
        "mix_norm": 1.0 + nrm(ks[8], (L, D), 0.01),
        "w_in": nrm(ks[9], (L, D, IN_COLS), D ** -0.5),
        "w_dw": nrm(ks[10], (L, CONV_KERNEL, CONV_WIDTH), CONV_KERNEL ** -0.5),
        "b_dw": nrm(ks[11], (L, CONV_WIDTH), 0.01),
        "conv_ln_w": 1.0 + nrm(ks[12], (L, CONV_WIDTH), 0.01),
        "conv_ln_b": nrm(ks[13], (L, CONV_WIDTH), 0.01),
        "w_short": nrm(ks[14], (L, SHORT_CONV, 3 * DN_WIDTH), SHORT_CONV ** -0.5),
        "a_log": jnp.log(jax.random.uniform(ks[15], (L, DN_HEADS), f32, 1.0, 16.0)),
        "dt_bias": dt + jnp.log(-jnp.expm1(-dt)),
        "dn_norm_w": 1.0 + nrm(ks[17], (L, DN_HEAD_DIM), 0.01),
        "w_out": nrm(ks[18], (L, D_MIX, D), D_MIX ** -0.5),
        "ffn2_norm": 1.0 + nrm(ks[19], (L, D), 0.01),
        "ffn2_wg": nrm(ks[20], (L, D, D_FF), D ** -0.5),
        "ffn2_wu": nrm(ks[21], (L, D, D_FF), D ** -0.5),
        "ffn2_wd": nrm(ks[22], (L, D_FF, D), D_FF ** -0.5),
        "final_norm": 1.0 + nrm(ks[23], (D,), 0.01),
    }


def reference(x, c, w_ada, b_ada, ffn1_norm, ffn1_wg, ffn1_wu, ffn1_wd, mix_norm, w_in,
              w_dw, b_dw, conv_ln_w, conv_ln_b, w_short, a_log, dt_bias, dn_norm_w, w_out,
              ffn2_norm, ffn2_wg, ffn2_wu, ffn2_wd, final_norm):
    B = x.shape[0]
    split_idx = list(np.cumsum(IN_SPLITS)[:-1])
    for l in range(DEPTH):
        mods = (jax.nn.silu(c) @ w_ada[l] + b_ada[l]).reshape(B, N_MOD, D_MODEL)
        h = modulate(rmsnorm(x, ffn1_norm[l]), mods[:, 0], mods[:, 1])
        x = x + 0.5 * mods[:, 2][:, None, :] * swiglu(h, ffn1_wg[l], ffn1_wu[l], ffn1_wd[l])
        h = modulate(rmsnorm(x, mix_norm[l]), mods[:, 3], mods[:, 4])
        p = h @ w_in[l]
        ca, cg, q, k, v, z, b_raw, a_raw = jnp.split(p, split_idx, axis=-1)
        y_conv = conformer_conv_group(ca, cg, w_dw[l], b_dw[l], conv_ln_w[l], conv_ln_b[l])
        y_dn = gated_deltanet_group(q, k, v, z, b_raw, a_raw, w_short[l], a_log[l],
                                    dt_bias[l], dn_norm_w[l])
        y = jnp.concatenate([y_conv, y_dn], axis=-1) @ w_out[l]
        x = x + mods[:, 5][:, None, :] * y
        h = modulate(rmsnorm(x, ffn2_norm[l]), mods[:, 6], mods[:, 7])
        x = x + 0.5 * mods[:, 8][:, None, :] * swiglu(h, ffn2_wg[l], ffn2_wu[l], ffn2_wd[l])
    return rmsnorm(x, final_norm)
```

```cpp
#include <hip/hip_runtime.h>
#include <hip/hip_cooperative_groups.h>
#include <cstdio>
namespace cg = cooperative_groups;

#ifndef MK_MULTI
#define MK_MULTI 0
#endif

#ifndef PROBE_REP_MASK
#define PROBE_REP_MASK 0
#endif
#ifndef PROBE_PREP_REP
#define PROBE_PREP_REP 1
#endif
#ifndef PROBE_CONV_REP
#define PROBE_CONV_REP 1
#endif
#ifndef PROBE_SYNC_REP
#define PROBE_SYNC_REP 1
#endif
#define LAS __attribute__((address_space(3)))
typedef unsigned short bf16_t;
typedef short bf16x8 __attribute__((ext_vector_type(8)));
typedef float f32x4 __attribute__((ext_vector_type(4)));
typedef float f32x2 __attribute__((ext_vector_type(2)));
typedef unsigned u32x4 __attribute__((ext_vector_type(4)));
typedef unsigned u32x2 __attribute__((ext_vector_type(2)));

constexpr int T_TOK = 16384, DM = 2048, DFF = 5632, NUP = 2 * DFF, SEQ = 4096, NB = 4;
constexpr int NIN_REAL = 6160, NIN = 6400, NMOD = 9 * DM;
constexpr int KS_ADA = 8;
constexpr int NCHUNK = 64, NHEAD = 8, NCH_TOT = NB * NHEAD * NCHUNK;
constexpr int OPS_BYTES = 73728;
constexpr int OPS_W = 0, OPS_Q = 16384, OPS_KT = 32768, OPS_A = 49152, OPS_U = 57344;
constexpr int LDS_BYTES = 163840;

constexpr size_t al256(size_t x) { return (x + 255) & ~(size_t)255; }
constexpr size_t WS_BAR = 0;
constexpr size_t WS_MODP = 16384;
constexpr size_t WS_MODS = al256(WS_MODP + (size_t)KS_ADA * NB * NMOD * 4);
constexpr size_t WS_GL   = al256(WS_MODS + (size_t)NB * NMOD * 4);
constexpr size_t WS_WUP  = al256(WS_GL + (size_t)NCH_TOT * 4);
constexpr size_t WS_WDN  = al256(WS_WUP + (size_t)NUP * DM * 2);
constexpr size_t WS_WIN  = al256(WS_WDN + (size_t)DM * DFF * 2);
constexpr size_t WS_WOUT = al256(WS_WIN + (size_t)NIN * DM * 2);
constexpr size_t WS_H    = al256(WS_WOUT + (size_t)DM * DM * 2);
constexpr size_t WS_BIG  = al256(WS_H + (size_t)T_TOK * DM * 2);
constexpr size_t WS_SCAN = al256(WS_BIG + (size_t)T_TOK * NIN * 2);
constexpr size_t WS_O    = al256(WS_SCAN + (size_t)NCH_TOT * OPS_BYTES);
constexpr size_t WS_END  = al256(WS_O + (size_t)T_TOK * 1024 * 4);

struct Params {
    const float *x, *c, *w_ada, *b_ada, *ffn1_norm, *ffn1_wg, *ffn1_wu, *ffn1_wd, *mix_norm, *w_in, *w_dw, *b_dw, *conv_ln_w, *conv_ln_b,
                *w_short, *a_log, *dt_bias, *dn_norm_w, *w_out, *ffn2_norm, *ffn2_wg, *ffn2_wu, *ffn2_wd, *final_norm;
    float* out; unsigned char* ws;
    int ph_lo, ph_hi;
};

typedef __bf16 bf16x2_t __attribute__((ext_vector_type(2)));
__device__ __forceinline__ unsigned cvt_pk_bf16(float lo, float hi) { const f32x2 v = {lo, hi}; const bf16x2_t r = __builtin_convertvector(v, bf16x2_t); return __builtin_bit_cast(unsigned, r); }
__device__ __forceinline__ float bf_lo(unsigned w) { return __uint_as_float(w << 16); }
__device__ __forceinline__ float bf_hi(unsigned w) { return __uint_as_float(w & 0xffff0000u); }
__device__ __forceinline__ float bf1(bf16_t v) { return __uint_as_float(((unsigned)v) << 16); }
__device__ __forceinline__ float wave_sum(float v) {
#pragma unroll
    for (int o = 1; o < 64; o <<= 1) v += __shfl_xor(v, o);
    return v;
}
#define LDS_BARRIER() do { asm volatile("s_waitcnt lgkmcnt(0)" ::: "memory"); __builtin_amdgcn_s_barrier(); asm volatile("" ::: "memory"); } while (0)
__device__ __forceinline__ float fast_sigmoid(float v) { return __builtin_amdgcn_rcpf(1.f + __builtin_amdgcn_exp2f(-1.44269504f * v)); }
__device__ __forceinline__ float fast_silu(float v) { return v * fast_sigmoid(v); }

namespace pg8 {
constexpr int BM = 256, BK = 64, HALF = 128, HTB = HALF * BK * 2, STAGE_BYTES = 8 * HTB, NXCD = 8, WGM = 4;
__host__ __device__ __forceinline__ int lds_byte(int r, int c) { const int st = (r >> 4) * 2 + (c >> 5), rr = r & 15, cc = c & 31, ob = rr * 64 + cc * 2; return st * 1024 + (ob ^ (((ob >> 9) & 1) << 5)); }
__host__ __device__ __forceinline__ void stage_rc(int b, int& R, int& C) { const int st = b / 1024, sb = b % 1024, swz = sb ^ (((sb >> 9) & 1) << 5); R = (st >> 1) * 16 + swz / 64; C = (st & 1) * 32 + (swz % 64) / 2; }
__host__ __device__ __forceinline__ int perm32(int rho) { const int n = rho >> 4, i = rho & 15; return 8 * (i >> 2) + 4 * n + (i & 3); }
struct Unit { int pm, pn; };
struct Gemm { const bf16_t* A; const bf16_t* Bt; int M, N, K; };
struct StaticOrder {
    int nM, nN, nwg, G, c, wgm;
    __host__ __device__ void init(int M, int N, int G_, int c_, int wgm_ = WGM) { nM = M / BM; nN = N / BM; nwg = nM * nN; G = G_; c = c_; wgm = wgm_; }
    __host__ __device__ bool next(int i, Unit& u) const {
        const long L = (long)i * G + c; if (L >= nwg) return false;
        int wgid = (int)L; { const int q = nwg / NXCD, r = nwg % NXCD, xcd = wgid % NXCD, off = wgid / NXCD; wgid = (xcd < r ? xcd * (q + 1) : r * (q + 1) + (xcd - r) * q) + off; }
        const int nig = wgm * nN, gid = wgid / nig, fm = gid * wgm, gsz = (nM - fm) < wgm ? (nM - fm) : wgm;
        u.pm = fm + ((wgid % nig) % gsz); u.pn = (wgid % nig) / gsz; return true;
    }
};

struct EpiSwiGLU {
    static constexpr bool PERM = true;
    bf16_t* O; int ldc;
    __device__ __forceinline__ void operator()(const f32x4 (&acc)[2][2][4][2], const Unit& u, int wr, int wc, int fr, int fq) const {
        const int row0 = u.pm * BM + wr * 64 + fr, col0 = u.pn * HALF + wc * 32 + 8 * fq;
#pragma unroll
        for (int ai = 0; ai < 2; ++ai)
#pragma unroll
            for (int m = 0; m < 4; ++m) {
                bf16_t* rowp = O + (size_t)(row0 + ai * HALF + m * 16) * ldc + col0;
                float v[8];
#pragma unroll
                for (int n = 0; n < 2; ++n)
#pragma unroll
                    for (int j = 0; j < 4; ++j) { const float g = acc[ai][0][m][n][j], uu = acc[ai][1][m][n][j]; v[n * 4 + j] = fast_silu(g) * uu; }
                u32x4 w; w.x = cvt_pk_bf16(v[0], v[1]); w.y = cvt_pk_bf16(v[2], v[3]); w.z = cvt_pk_bf16(v[4], v[5]); w.w = cvt_pk_bf16(v[6], v[7]);
                *(u32x4*)rowp = w;
            }
    }
};
struct EpiResid {
    static constexpr bool PERM = false;
    const float* base; float* out; const float* gate; float gs;
    __device__ __forceinline__ void operator()(const f32x4 (&acc)[2][2][4][2], const Unit& u, int wr, int wc, int fr, int fq) const {
        const int row0 = u.pm * BM + wr * 64 + fr, col0 = u.pn * BM + wc * 32 + 4 * fq, b = u.pm >> 4;
        f32x4 gv[2][2];
#pragma unroll
        for (int bj = 0; bj < 2; ++bj)
#pragma unroll
            for (int n = 0; n < 2; ++n) gv[bj][n] = *(const f32x4*)(gate + (size_t)b * NMOD + col0 + bj * HALF + n * 16) * gs;
#pragma unroll
        for (int ai = 0; ai < 2; ++ai)
#pragma unroll
            for (int m = 0; m < 4; ++m) {
                const size_t off = (size_t)(row0 + ai * HALF + m * 16) * DM + col0;
#pragma unroll
                for (int bj = 0; bj < 2; ++bj)
#pragma unroll
                    for (int n = 0; n < 2; ++n) { const f32x4 bb = *(const f32x4*)(base + off + bj * HALF + n * 16); *(f32x4*)(out + off + bj * HALF + n * 16) = bb + gv[bj][n] * acc[ai][bj][m][n]; }
            }
    }
};
template <bool BASE_BF16, bool HALFG> struct EpiResidB {
    static constexpr bool PERM = false;
    const void* base; bf16_t* out; const float* gate;
    static constexpr float gs = HALFG ? 0.5f : 1.0f;
    __device__ __forceinline__ void operator()(const f32x4 (&acc)[2][2][4][2], const Unit& u, int wr, int wc, int fr, int fq) const {
        const int row0 = u.pm * BM + wr * 64 + fr, col0 = u.pn * BM + wc * 32 + 4 * fq, b = u.pm >> 4;
        f32x4 gv[2][2];
#pragma unroll
        for (int bj = 0; bj < 2; ++bj)
#pragma unroll
            for (int n = 0; n < 2; ++n) gv[bj][n] = *(const f32x4*)(gate + (size_t)b * NMOD + col0 + bj * HALF + n * 16) * gs;
#pragma unroll
        for (int ai = 0; ai < 2; ++ai)
#pragma unroll
            for (int m = 0; m < 4; ++m) {
                const size_t off = (size_t)(row0 + ai * HALF + m * 16) * DM + col0;
#pragma unroll
                for (int bj = 0; bj < 2; ++bj)
#pragma unroll
                    for (int n = 0; n < 2; ++n) {
                        f32x4 bb;
                        if (BASE_BF16) { const u32x2 r = *(const u32x2*)((const bf16_t*)base + off + bj * HALF + n * 16); bb = (f32x4){bf_lo(r.x), bf_hi(r.x), bf_lo(r.y), bf_hi(r.y)}; }
                        else bb = *(const f32x4*)((const float*)base + off + bj * HALF + n * 16);
                        const f32x4 xn = bb + gv[bj][n] * acc[ai][bj][m][n];
                        u32x2 w; w.x = cvt_pk_bf16(xn[0], xn[1]); w.y = cvt_pk_bf16(xn[2], xn[3]);
                        *(u32x2*)(out + off + bj * HALF + n * 16) = w;
                    }
            }
    }
};
struct EpiFinal {
    static constexpr bool PERM = false;
    const bf16_t* base; float* out; const float* gate; const float* fw; float* rowss; unsigned* cnt;
    __device__ __forceinline__ void operator()(f32x4 (&acc)[2][2][4][2], const Unit& u, int wr, int wc, int fr, int fq) const {
        const int row0 = u.pm * BM + wr * 64 + fr, col0 = u.pn * BM + wc * 32 + 4 * fq, b = u.pm >> 4;
        f32x4 gv[2][2];
#pragma unroll
        for (int bj = 0; bj < 2; ++bj)
#pragma unroll
            for (int n = 0; n < 2; ++n) gv[bj][n] = *(const f32x4*)(gate + (size_t)b * NMOD + col0 + bj * HALF + n * 16) * 0.5f;
#pragma unroll
        for (int ai = 0; ai < 2; ++ai)
#pragma unroll
            for (int m = 0; m < 4; ++m) {
                const int row = row0 + ai * HALF + m * 16;
                const size_t off = (size_t)row * DM + col0;
                float ss = 0.f;
#pragma unroll
                for (int bj = 0; bj < 2; ++bj)
#pragma unroll
                    for (int n = 0; n < 2; ++n) {
                        const u32x2 r = *(const u32x2*)(base + off + bj * HALF + n * 16);
                        const f32x4 bb = (f32x4){bf_lo(r.x), bf_hi(r.x), bf_lo(r.y), bf_hi(r.y)};
                        const f32x4 xn = bb + gv[bj][n] * acc[ai][bj][m][n];
                        acc[ai][bj][m][n] = xn;
                        ss += (xn[0] * xn[0] + xn[1] * xn[1]) + (xn[2] * xn[2] + xn[3] * xn[3]);
                    }
                ss += __shfl_xor(ss, 16); ss += __shfl_xor(ss, 32);
                if (fq == 0) (void)__hip_atomic_fetch_add(rowss + row, ss, __ATOMIC_RELAXED, __HIP_MEMORY_SCOPE_AGENT);
            }
        asm volatile("s_waitcnt vmcnt(0)" ::: "memory");
        unsigned* pc = cnt + u.pm * 2 + wr;
        if ((threadIdx.x & 63) == 0) (void)__hip_atomic_fetch_add(pc, 1u, __ATOMIC_RELEASE, __HIP_MEMORY_SCOPE_AGENT);
        { unsigned sp = 0; while (__hip_atomic_load(pc, __ATOMIC_RELAXED, __HIP_MEMORY_SCOPE_AGENT) < 32u) { __builtin_amdgcn_s_sleep(2); if (++sp > (1u << 22)) break; } }
        __builtin_amdgcn_fence(__ATOMIC_ACQUIRE, "agent");
#pragma unroll
        for (int ai = 0; ai < 2; ++ai)
#pragma unroll
            for (int m = 0; m < 4; ++m) {
                const int row = row0 + ai * HALF + m * 16;
                const float tot = __hip_atomic_load(rowss + row, __ATOMIC_RELAXED, __HIP_MEMORY_SCOPE_AGENT);
                const float rstd = 1.f / sqrtf(tot * (1.f / DM) + 1e-6f);
                float* op = out + (size_t)row * DM + col0;
#pragma unroll
                for (int bj = 0; bj < 2; ++bj)
#pragma unroll
                    for (int n = 0; n < 2; ++n) { const f32x4 w = *(const f32x4*)(fw + col0 + bj * HALF + n * 16);
                        __builtin_nontemporal_store(acc[ai][bj][m][n] * rstd * w, (f32x4*)(op + bj * HALF + n * 16)); }
            }
    }
};
struct EpiBf16 {
    static constexpr bool PERM = true;
    bf16_t* O; int ldc;
    __device__ __forceinline__ void operator()(const f32x4 (&acc)[2][2][4][2], const Unit& u, int wr, int wc, int fr, int fq) const {
        const int row0 = u.pm * BM + wr * 64 + fr, col0 = u.pn * BM + wc * 32 + 8 * fq;
#pragma unroll
        for (int ai = 0; ai < 2; ++ai)
#pragma unroll
            for (int m = 0; m < 4; ++m) {
                bf16_t* rowp = O + (size_t)(row0 + ai * HALF + m * 16) * ldc + col0;
#pragma unroll
                for (int bj = 0; bj < 2; ++bj) { const f32x4 v0 = acc[ai][bj][m][0], v1 = acc[ai][bj][m][1];
                    u32x4 w; w.x = cvt_pk_bf16(v0[0], v0[1]); w.y = cvt_pk_bf16(v0[2], v0[3]); w.z = cvt_pk_bf16(v1[0], v1[1]); w.w = cvt_pk_bf16(v1[2], v1[3]);
                    *(u32x4*)(rowp + bj * HALF) = w; }
            }
    }
};

template <class Epi>
__device__ __forceinline__ void gemm_phase(LAS unsigned char* lds, const Gemm g, const StaticOrder& S, const Epi& E) {
    const int tid = threadIdx.x, wid = __builtin_amdgcn_readfirstlane(tid >> 6), lane = tid & 63, wr = wid >> 2, wc = wid & 3, fr = lane & 15, fq = lane >> 4;
    const int K = g.K, nt = K / BK;
    unsigned voffA[2], voffB[2];
#pragma unroll
    for (int i = 0; i < 2; ++i) { int R, C; stage_rc(tid * 16 + i * 8192, R, C); const int Rb = Epi::PERM ? ((R & ~31) + perm32(R & 31)) : R;
        voffA[i] = (unsigned)(R * K + C) * 2u; voffB[i] = (unsigned)(Rb * K + C) * 2u; }
    const size_t kstep = (size_t)(BK * 2);
    const size_t hstep = (size_t)HALF * K * 2;
    const size_t tstep = 2 * hstep;
    const unsigned ldsw = (unsigned)wid * 1024u;
    const int aoff = lds_byte(wr * 64 + fr, fq * 8), boff = lds_byte(wc * 32 + fr, fq * 8);
#define PG8_SA(b, h) (((b) * 2 + (h)) * HTB)
#define PG8_SB(b, h) ((4 + (b) * 2 + (h)) * HTB)
#define PG8_STAGE(bufoff, gbase, voff) do { _Pragma("unroll") for (int _i = 0; _i < 2; ++_i) \
        __builtin_amdgcn_global_load_lds((const unsigned*)((const char*)(gbase) + (voff)[_i]), (LAS unsigned*)(lds + (bufoff) + ldsw + _i * 8192), 16, 0, 0); } while (0)
#define PG8_LDA(dst, b, h) do { _Pragma("unroll") for (int m = 0; m < 4; ++m) _Pragma("unroll") for (int k = 0; k < 2; ++k) dst[m][k] = *(const LAS bf16x8*)(lds + PG8_SA(b, h) + aoff + m * 2048 + k * 1024); } while (0)
#define PG8_LDB(dst, b, h) do { _Pragma("unroll") for (int n = 0; n < 2; ++n) _Pragma("unroll") for (int k = 0; k < 2; ++k) dst[n][k] = *(const LAS bf16x8*)(lds + PG8_SB(b, h) + boff + n * 2048 + k * 1024); } while (0)
#define PG8_MMA(ai, bj, At, Bt) do { __builtin_amdgcn_s_setprio(1); _Pragma("unroll") for (int m = 0; m < 4; ++m) _Pragma("unroll") for (int n = 0; n < 2; ++n) _Pragma("unroll") for (int k = 0; k < 2; ++k) \
        acc[ai][bj][m][n] = __builtin_amdgcn_mfma_f32_16x16x32_bf16(Bt[n][k], At[m][k], acc[ai][bj][m][n], 0, 0, 0); __builtin_amdgcn_s_setprio(0); } while (0)
#define PG8_WAIT_V(n) asm volatile("s_waitcnt vmcnt(" #n ")" ::: "memory")
#define PG8_WAIT_L(n) asm volatile("s_waitcnt lgkmcnt(" #n ")" ::: "memory")
#define PG8_BAR __builtin_amdgcn_s_barrier()
#define PG8_SCHED __builtin_amdgcn_sched_barrier(0)
    Unit cur, nxt; int ui = 0;
    if (!S.next(0, cur)) return;
    f32x4 acc[2][2][4][2];
#pragma unroll
    for (int a = 0; a < 2; ++a)
#pragma unroll
        for (int b = 0; b < 2; ++b)
#pragma unroll
            for (int m = 0; m < 4; ++m)
#pragma unroll
                for (int n = 0; n < 2; ++n) acc[a][b][m][n] = (f32x4){0.f, 0.f, 0.f, 0.f};
    bf16x8 At[4][2], B0[2][2], B1[2][2];
    const char* cA = (const char*)g.A + (size_t)cur.pm * tstep; const char* cB = (const char*)g.Bt + (size_t)cur.pn * tstep;
    PG8_STAGE(PG8_SB(0, 0), cB, voffB); PG8_STAGE(PG8_SA(0, 0), cA, voffA); PG8_STAGE(PG8_SB(0, 1), cB + hstep, voffB); PG8_STAGE(PG8_SA(0, 1), cA + hstep, voffA);
    if (wr == 1) PG8_BAR;
    PG8_WAIT_V(4); PG8_BAR;
    PG8_STAGE(PG8_SB(1, 0), cB + kstep, voffB); PG8_STAGE(PG8_SA(1, 0), cA + kstep, voffA); PG8_STAGE(PG8_SB(1, 1), cB + hstep + kstep, voffB);
    PG8_WAIT_V(6); PG8_BAR;
    for (;;) {
        const bool has_next = S.next(ui + 1, nxt);
        const char* nA = has_next ? (const char*)g.A + (size_t)nxt.pm * tstep : cA; const char* nB = has_next ? (const char*)g.Bt + (size_t)nxt.pn * tstep : cB;
        for (int t = 0; t < nt; t += 2) {
            const bool last = (t == nt - 2);
            const char* a1 = cA + (size_t)(t + 1) * kstep;
            const char* a2 = last ? nA : cA + (size_t)(t + 2) * kstep; const char* b2 = last ? nB : cB + (size_t)(t + 2) * kstep;
            const char* a3 = a2 + kstep; const char* b3 = b2 + kstep;
            PG8_LDB(B0, 0, 0); PG8_SCHED; PG8_LDA(At, 0, 0); PG8_STAGE(PG8_SA(1, 1), a1 + hstep, voffA);
            PG8_WAIT_L(8); PG8_BAR; PG8_WAIT_L(0); PG8_MMA(0, 0, At, B0); PG8_BAR; PG8_SCHED;
            PG8_LDB(B1, 0, 1); PG8_STAGE(PG8_SB(0, 0), b2, voffB);
            PG8_BAR; PG8_WAIT_L(0); PG8_MMA(0, 1, At, B1); PG8_BAR;
            PG8_LDA(At, 0, 1); PG8_STAGE(PG8_SA(0, 0), a2, voffA);
            PG8_BAR; PG8_WAIT_L(0); PG8_MMA(1, 0, At, B0); PG8_BAR; PG8_SCHED;
            PG8_STAGE(PG8_SB(0, 1), b2 + hstep, voffB);
            PG8_WAIT_V(6); PG8_BAR; PG8_MMA(1, 1, At, B1); PG8_BAR;
            PG8_LDB(B0, 1, 0); PG8_SCHED; PG8_LDA(At, 1, 0); PG8_STAGE(PG8_SA(0, 1), a2 + hstep, voffA);
            PG8_WAIT_L(8); PG8_BAR; PG8_WAIT_L(0); PG8_MMA(0, 0, At, B0); PG8_BAR; PG8_SCHED;
            PG8_LDB(B1, 1, 1); PG8_STAGE(PG8_SB(1, 0), b3, voffB);
            PG8_BAR; PG8_WAIT_L(0); PG8_MMA(0, 1, At, B1); PG8_BAR;
            PG8_LDA(At, 1, 1); PG8_STAGE(PG8_SA(1, 0), a3, voffA);
            PG8_BAR; PG8_WAIT_L(0); PG8_MMA(1, 0, At, B0); PG8_BAR; PG8_SCHED;
            PG8_STAGE(PG8_SB(1, 1), b3 + hstep, voffB);
            PG8_WAIT_V(6); PG8_BAR; PG8_MMA(1, 1, At, B1); PG8_BAR;
        }
        E(acc, cur, wr, wc, fr, fq);
        if (!has_next) break;
#pragma unroll
        for (int a = 0; a < 2; ++a)
#pragma unroll
            for (int b = 0; b < 2; ++b)
#pragma unroll
                for (int m = 0; m < 4; ++m)
#pragma unroll
                    for (int n = 0; n < 2; ++n) acc[a][b][m][n] = (f32x4){0.f, 0.f, 0.f, 0.f};
        cur = nxt; cA = nA; cB = nB; ++ui;
    }
    PG8_WAIT_V(0);
    if (wr == 0) PG8_BAR;
    PG8_BAR;
#undef PG8_SA
#undef PG8_SB
#undef PG8_STAGE
#undef PG8_LDA
#undef PG8_LDB
#undef PG8_MMA
#undef PG8_WAIT_V
#undef PG8_WAIT_L
#undef PG8_BAR
#undef PG8_SCHED
}
}

__device__ __forceinline__ void gemv_item(const Params& P, LAS unsigned char* lds, int item) {
    const int cgp = item % 72, ks = item / 72;
    const int tid = threadIdx.x, lane = tid & 63, wid = tid >> 6;
    LAS float* sc = (LAS float*)lds;
    LAS float* red = (LAS float*)(lds + 4096);
    for (int i = tid; i < 1024; i += 512) { const int b = i >> 8, kk = i & 255; const float v = P.c[b * DM + ks * 256 + kk]; sc[i] = v / (1.f + __expf(-v)); }
    LDS_BARRIER();
    float acc[4][4];
#pragma unroll
    for (int b = 0; b < 4; ++b)
#pragma unroll
        for (int e = 0; e < 4; ++e) acc[b][e] = 0.f;
    const float* wp = P.w_ada + (size_t)(ks * 256 + wid * 32) * NMOD + cgp * 256 + lane * 4;
#pragma unroll 8
    for (int r = 0; r < 32; ++r) {
        const f32x4 w = __builtin_nontemporal_load((const f32x4*)(wp + (size_t)r * NMOD));
        const int kk = wid * 32 + r;
#pragma unroll
        for (int b = 0; b < 4; ++b) { const float s = sc[b * 256 + kk];
#pragma unroll
            for (int e = 0; e < 4; ++e) acc[b][e] += s * w[e]; }
    }
#pragma unroll
    for (int b = 0; b < 4; ++b)
#pragma unroll
        for (int e = 0; e < 4; ++e) red[(wid * 16 + b * 4 + e) * 64 + lane] = acc[b][e];
    LDS_BARRIER();
    float* modp = (float*)(P.ws + WS_MODP);
    for (int o = tid; o < 1024; o += 512) { const int be = o >> 6, ln = o & 63; float s = 0.f;
#pragma unroll
        for (int w = 0; w < 8; ++w) s += red[(w * 16 + be) * 64 + ln];
        const int b = be >> 2, e = be & 3; modp[((size_t)ks * NB + b) * NMOD + cgp * 256 + ln * 4 + e] = s; }
    LDS_BARRIER();
}
__device__ __forceinline__ void wconv_tile(const float* W, int N, int k0, int n0, bf16_t* Bt, int Kd, int mode, LAS unsigned char* lds) {
    LAS float* tile = (LAS float*)lds;
    const int tid = threadIdx.x, col = tid & 255, rh = tid >> 8;
    float v[32];
    const bool ok = (n0 + col) < N;
    const float* src = W + (size_t)(k0 + rh) * N + n0 + col;
#pragma unroll
    for (int i = 0; i < 32; ++i) v[i] = ok ? __builtin_nontemporal_load(src + (size_t)(2 * i) * N) : 0.f;
#pragma unroll
    for (int i = 0; i < 32; ++i) tile[(2 * i + rh) * 257 + col] = v[i];
    LDS_BARRIER();
#pragma unroll
    for (int i = 0; i < 4; ++i) {
        const int o = tid + 512 * i, kg = o & 7, n = o >> 3;
        float f[8];
#pragma unroll
        for (int j = 0; j < 8; ++j) f[j] = tile[(8 * kg + j) * 257 + n];
        u32x4 w; w.x = cvt_pk_bf16(f[0], f[1]); w.y = cvt_pk_bf16(f[2], f[3]); w.z = cvt_pk_bf16(f[4], f[5]); w.w = cvt_pk_bf16(f[6], f[7]);
        const int nc = n0 + n;
        const int R = (mode == 0) ? nc : (256 * (nc >> 7) + (nc & 127) + (mode == 2 ? 128 : 0));
        *(u32x4*)(Bt + (size_t)R * Kd + k0 + 8 * kg) = w;
    }
    LDS_BARRIER();
}
constexpr int NT_FFN = 3 * 704, NT_WIN = 800, NT_WOUT = 256;
__device__ __forceinline__ void wconv_ffn_item(const Params& P, LAS unsigned char* lds, int i, const float* wg, const float* wu, const float* wd) {
    bf16_t* WUP = (bf16_t*)(P.ws + WS_WUP); bf16_t* WDN = (bf16_t*)(P.ws + WS_WDN);
    if (i < 704) wconv_tile(wg, DFF, (i / 22) * 64, (i % 22) * 256, WUP, DM, 1, lds);
    else if (i < 1408) { i -= 704; wconv_tile(wu, DFF, (i / 22) * 64, (i % 22) * 256, WUP, DM, 2, lds); }
    else { i -= 1408; wconv_tile(wd, DM, (i / 8) * 64, (i % 8) * 256, WDN, DFF, 0, lds); }
}
__device__ __forceinline__ void phase0(const Params& P, LAS unsigned char* lds) {
    constexpr int N_GEMV = 72 * KS_ADA;
    constexpr int NITEMS = N_GEMV + NT_FFN + NT_WIN + NT_WOUT;
    for (int it = blockIdx.x; it < NITEMS; it += gridDim.x) {
        int i = it;
        if (i < N_GEMV) { gemv_item(P, lds, i); continue; } i -= N_GEMV;
        if (i < NT_FFN) { wconv_ffn_item(P, lds, i, P.ffn1_wg, P.ffn1_wu, P.ffn1_wd); continue; } i -= NT_FFN;
        if (i < NT_WIN) { wconv_tile(P.w_in, NIN_REAL, (i / 25) * 64, (i % 25) * 256, (bf16_t*)(P.ws + WS_WIN), DM, 0, lds); continue; } i -= NT_WIN;
        wconv_tile(P.w_out, DM, (i / 8) * 64, (i % 8) * 256, (bf16_t*)(P.ws + WS_WOUT), DM, 0, lds);
    }
}

template <bool IN_BF16> __device__ __forceinline__ void norm_mod_phase(const Params& P, LAS unsigned char* lds, const void* xin_, const float* normw, int idx, bool from_partials, bf16_t* hout) {
    LAS float* As = (LAS float*)lds; LAS float* Bs = As + DM;
    const int tid = threadIdx.x, lane = tid & 63, wid = tid >> 6;
    const float* modp = (const float*)(P.ws + WS_MODP); const float* mods = (const float*)(P.ws + WS_MODS);
    for (int rb = blockIdx.x; rb < T_TOK / 64; rb += gridDim.x) {
        const int b = rb >> 6;
        __syncthreads();
        for (int k = tid; k < DM; k += 512) {
            float sh, sc;
            if (from_partials) {
                sh = P.b_ada[idx * DM + k]; sc = P.b_ada[(idx + 1) * DM + k];
#pragma unroll
                for (int s = 0; s < KS_ADA; ++s) { sh += modp[((size_t)s * NB + b) * NMOD + idx * DM + k]; sc += modp[((size_t)s * NB + b) * NMOD + (idx + 1) * DM + k]; }
            } else { sh = mods[(size_t)b * NMOD + idx * DM + k]; sc = mods[(size_t)b * NMOD + (idx + 1) * DM + k]; }
            As[k] = normw[k] * (1.f + sc); Bs[k] = sh;
        }
        __syncthreads();
        for (int rr = wid; rr < 64; rr += 16) {
            const int row0 = rb * 64 + rr, row1 = row0 + 8;
            f32x4 v0[8], v1[8]; float ss0 = 0.f, ss1 = 0.f;
            if (IN_BF16) {
                const u32x2* xr0 = (const u32x2*)((const bf16_t*)xin_ + (size_t)row0 * DM) + lane; const u32x2* xr1 = (const u32x2*)((const bf16_t*)xin_ + (size_t)row1 * DM) + lane;
                u32x2 r0[8], r1[8];
#pragma unroll
                for (int i = 0; i < 8; ++i) { r0[i] = xr0[64 * i]; r1[i] = xr1[64 * i]; }
#pragma unroll
                for (int i = 0; i < 8; ++i) { v0[i] = (f32x4){bf_lo(r0[i].x), bf_hi(r0[i].x), bf_lo(r0[i].y), bf_hi(r0[i].y)}; v1[i] = (f32x4){bf_lo(r1[i].x), bf_hi(r1[i].x), bf_lo(r1[i].y), bf_hi(r1[i].y)}; }
            } else {
                const f32x4* xr0 = (const f32x4*)((const float*)xin_ + (size_t)row0 * DM) + lane; const f32x4* xr1 = (const f32x4*)((const float*)xin_ + (size_t)row1 * DM) + lane;
#pragma unroll
                for (int i = 0; i < 8; ++i) { v0[i] = xr0[64 * i]; v1[i] = xr1[64 * i]; }
            }
#pragma unroll
            for (int i = 0; i < 8; ++i) { ss0 += (v0[i].x * v0[i].x + v0[i].y * v0[i].y) + (v0[i].z * v0[i].z + v0[i].w * v0[i].w);
                                          ss1 += (v1[i].x * v1[i].x + v1[i].y * v1[i].y) + (v1[i].z * v1[i].z + v1[i].w * v1[i].w); }
#pragma unroll
            for (int o = 1; o < 64; o <<= 1) { const float t0 = __shfl_xor(ss0, o), t1 = __shfl_xor(ss1, o); ss0 += t0; ss1 += t1; }
            const float rstd0 = 1.f / sqrtf(ss0 * (1.f / DM) + 1e-6f), rstd1 = 1.f / sqrtf(ss1 * (1.f / DM) + 1e-6f);
            u32x2* o80 = (u32x2*)(hout + (size_t)row0 * DM) + lane; u32x2* o81 = (u32x2*)(hout + (size_t)row1 * DM) + lane;
#pragma unroll
            for (int i = 0; i < 8; ++i) { const int k = (lane + 64 * i) * 4;
                const f32x4 a = *(const LAS f32x4*)(As + k), bb = *(const LAS f32x4*)(Bs + k);
                const f32x4 p0 = v0[i] * rstd0 * a + bb, p1 = v1[i] * rstd1 * a + bb;
                u32x2 w; w.x = cvt_pk_bf16(p0.x, p0.y); w.y = cvt_pk_bf16(p0.z, p0.w); o80[64 * i] = w;
                w.x = cvt_pk_bf16(p1.x, p1.y); w.y = cvt_pk_bf16(p1.z, p1.w); o81[64 * i] = w; }
        }
    }
}
__device__ __forceinline__ void mods_finalize(const Params& P) {
    const float* modp = (const float*)(P.ws + WS_MODP); float* mods = (float*)(P.ws + WS_MODS);
    for (int i = blockIdx.x * 512 + threadIdx.x; i < NB * NMOD; i += gridDim.x * 512) {
        const int b = i / NMOD, col = i % NMOD; float s = P.b_ada[col];
#pragma unroll
        for (int ks = 0; ks < KS_ADA; ++ks) s += modp[((size_t)ks * NB + b) * NMOD + col];
        mods[i] = s;
    }
}

__device__ __forceinline__ void gate_cols_phase(const Params& P, LAS unsigned char* lds) {
    const bf16_t* Hh = (const bf16_t*)(P.ws + WS_H); const bf16_t* WINp = (const bf16_t*)(P.ws + WS_WIN); bf16_t* PB = (bf16_t*)(P.ws + WS_BIG);
    const int tid = threadIdx.x, lane = tid & 63, wid = tid >> 6, fr = lane & 15, fq = lane >> 4, mt = wid & 3, kh = wid >> 2;
    LAS f32x4* part = (LAS f32x4*)lds;
    for (int rb = blockIdx.x; rb < T_TOK / 64; rb += gridDim.x) {
        const bf16_t* ap = Hh + (size_t)(rb * 64 + 16 * mt + fr) * DM + kh * 1024 + 8 * fq;
        const bf16_t* bp = WINp + (size_t)(6144 + fr) * DM + kh * 1024 + 8 * fq;
        f32x4 acc = (f32x4){0.f, 0.f, 0.f, 0.f};
#pragma unroll 1
        for (int k0 = 0; k0 < 32; k0 += 8) {
            bf16x8 a[8], b[8];
#pragma unroll
            for (int i = 0; i < 8; ++i) { a[i] = *(const bf16x8*)(ap + (k0 + i) * 32); b[i] = *(const bf16x8*)(bp + (k0 + i) * 32); }
#pragma unroll
            for (int i = 0; i < 8; ++i) acc = __builtin_amdgcn_mfma_f32_16x16x32_bf16(a[i], b[i], acc, 0, 0, 0);
        }
        LDS_BARRIER();
        if (kh == 1) part[mt * 64 + lane] = acc;
        LDS_BARRIER();
        if (kh == 0) {
            acc += part[mt * 64 + lane];
            bf16_t* op = PB + (size_t)(rb * 64 + 16 * mt + 4 * fq) * NIN + 6144 + fr;
#pragma unroll
            for (int j = 0; j < 4; ++j) op[(size_t)j * NIN] = (bf16_t)(cvt_pk_bf16(acc[j], 0.f) & 0xffffu);
        }
    }
}

__device__ __forceinline__ void conv_item(const Params& P, LAS unsigned char* lds, int item) {
    const bf16_t* PB = (const bf16_t*)(P.ws + WS_BIG); bf16_t* Y = (bf16_t*)(P.ws + WS_H);
    const int tid = threadIdx.x;
    const int b = item >> 7, t0 = (item & 127) * 32, ch = tid * 2;
    LAS unsigned* hs = (LAS unsigned*)lds + tid;
    LAS float* ps = (LAS float*)lds;
    LAS float* stat = (LAS float*)(lds + 131072);
    const bf16_t* colp = PB + (size_t)b * SEQ * NIN + ch;
#pragma unroll 1
    for (int j0 = 0; j0 < 64; j0 += 16) {
        unsigned ra[16], rg[16];
#pragma unroll
        for (int jj = 0; jj < 16; ++jj) { const int j = j0 + jj, tt = t0 - 30 + j, tc = tt < 0 ? 0 : (j < 62 ? tt : t0);
            const bf16_t* rp = colp + (size_t)tc * NIN; ra[jj] = *(const unsigned*)rp; rg[jj] = *(const unsigned*)(rp + 1024); }
#pragma unroll
        for (int jj = 0; jj < 16; ++jj) { const int j = j0 + jj, tt = t0 - 30 + j;
            float h0 = bf_lo(ra[jj]) * fast_sigmoid(bf_lo(rg[jj])), h1 = bf_hi(ra[jj]) * fast_sigmoid(bf_hi(rg[jj]));
            const bool ok = (tt >= 0) && (j < 62);
            h0 = ok ? h0 : 0.f; h1 = ok ? h1 : 0.f;
            if (j < 63) hs[j * 512] = cvt_pk_bf16(h0, h1); }
    }
    float acc0[32], acc1[32];
#pragma unroll
    for (int i = 0; i < 32; ++i) { acc0[i] = 0.f; acc1[i] = 0.f; }
#pragma unroll 1
    for (int g = 0; g < 8; ++g) {
        f32x2 w[4];
#pragma unroll
        for (int t = 0; t < 4; ++t) { const int tap = 4 * g + t; w[t] = *(const f32x2*)(P.w_dw + (tap < 31 ? tap : 30) * 1024 + ch); if (tap >= 31) w[t] = (f32x2){0.f, 0.f}; }
        const LAS unsigned* hp = hs + g * 4 * 512;
        float hl[35], hh[35];
#pragma unroll
        for (int r = 0; r < 35; ++r) { const unsigned hv = hp[r * 512]; hl[r] = bf_lo(hv); hh[r] = bf_hi(hv); }
#pragma unroll
        for (int i = 0; i < 32; ++i)
#pragma unroll
            for (int t = 0; t < 4; ++t) { acc0[i] += w[t].x * hl[i + t]; acc1[i] += w[t].y * hh[i + t]; }
    }
    const f32x2 bd = *(const f32x2*)(P.b_dw + ch);
    LDS_BARRIER();
#pragma unroll
    for (int i = 0; i < 32; ++i) {
        acc0[i] += bd.x; acc1[i] += bd.y;
        ps[i * 512 + tid] = acc0[i] + acc1[i];
        ps[16384 + i * 512 + tid] = acc0[i] * acc0[i] + acc1[i] * acc1[i];
    }
    LDS_BARRIER();
    {
        const int tok = tid >> 4, part = tid & 15;
        float s = 0.f, q = 0.f;
#pragma unroll
        for (int k = 0; k < 8; ++k) { const int off = tok * 512 + part * 32 + ((k + part) & 7) * 4;
            const f32x4 a = *(const LAS f32x4*)(ps + off), c = *(const LAS f32x4*)(ps + 16384 + off);
            s += (a[0] + a[1]) + (a[2] + a[3]); q += (c[0] + c[1]) + (c[2] + c[3]); }
#pragma unroll
        for (int o = 1; o < 16; o <<= 1) { s += __shfl_xor(s, o); q += __shfl_xor(q, o); }
        if (part == 0) { const float mu = s * (1.f / 1024.f), var = fmaxf(q * (1.f / 1024.f) - mu * mu, 0.f);
            stat[tok * 2] = mu; stat[tok * 2 + 1] = 1.f / sqrtf(var + 1e-6f); }
    }
    LDS_BARRIER();
    const f32x2 lw = *(const f32x2*)(P.conv_ln_w + ch), lb = *(const f32x2*)(P.conv_ln_b + ch);
    bf16_t* yp = Y + (size_t)(b * SEQ + t0) * DM + ch;
#pragma unroll
    for (int i = 0; i < 32; ++i) {
        const float mu = stat[i * 2], rstd = stat[i * 2 + 1];
        const float y0 = (acc0[i] - mu) * rstd * lw.x + lb.x, y1 = (acc1[i] - mu) * rstd * lw.y + lb.y;
        *(unsigned*)(yp + (size_t)i * DM) = cvt_pk_bf16(fast_silu(y0), fast_silu(y1));
    }
    LDS_BARRIER();
}

constexpr int PL_KH = 0, PL_QH = 17408, PL_RHS = 34816, PL_LM = 100352, PL_G = 117760, PL_BETA = 118016, PL_END = 118272;
constexpr int KH_STRIDE = 272;
constexpr int LM_STRIDE = 68;

__device__ __forceinline__ void dn_gate_load(const Params& P, int ch, float& gb, float& ga) {
    const bf16_t* PB = (const bf16_t*)(P.ws + WS_BIG);
    const int bh = ch >> 6, n = ch & 63, b = bh >> 3, h = bh & 7;
    const bf16_t* rp = PB + ((size_t)b * SEQ + n * 64 + (threadIdx.x & 63)) * NIN + 6144 + h;
    gb = bf1(rp[0]); ga = bf1(rp[8]);
}
__device__ __forceinline__ void dn_prep_chunk(const Params& P, LAS unsigned char* lds, int ch, float& gb, float& ga, int ch_next) {
    const bf16_t* PB = (const bf16_t*)(P.ws + WS_BIG);
    unsigned char* ops = P.ws + WS_SCAN + (size_t)ch * OPS_BYTES;
    const int tid = threadIdx.x, lane = tid & 63, wid = tid >> 6;
    const int bh = ch >> 6, n = ch & 63, b = bh >> 3, h = bh & 7;
    const size_t tok0 = (size_t)b * SEQ + n * 64;
    LAS float* Gs = (LAS float*)(lds + PL_G); LAS float* Bes = (LAS float*)(lds + PL_BETA);
    LAS float* RHS = (LAS float*)(lds + PL_RHS); LAS float* LM = (LAS float*)(lds + PL_LM);
    const int r0 = 4 * (tid >> 5), d4 = 4 * (tid & 31);
    u32x2 raw[3][7];
#pragma unroll
    for (int X = 0; X < 3; ++X)
#pragma unroll
        for (int j = 0; j < 7; ++j) {
            const int tl = n * 64 + r0 - 3 + j, tlc = tl < 0 ? 0 : tl;
            const u32x2 v = *(const u32x2*)(PB + ((size_t)b * SEQ + tlc) * NIN + 2048 + 1024 * X + h * 128 + d4);
            raw[X][j].x = tl >= 0 ? v.x : 0u; raw[X][j].y = tl >= 0 ? v.y : 0u;
        }
    if (wid == 0) {
        const float braw = gb, araw = ga;
        if (ch_next >= 0) dn_gate_load(P, ch_next, gb, ga);
        const float beta = 1.f / (1.f + __expf(-braw));
        const float xx = araw + P.dt_bias[h];
        const float sp = (xx > 20.f) ? xx : log1pf(__expf(xx));
        float g = -__expf(P.a_log[h]) * sp;
#pragma unroll
        for (int o = 1; o < 64; o <<= 1) { const float t = __shfl_up(g, o); if (lane >= o) g += t; }
        Gs[lane] = g; Bes[lane] = beta;
        if (lane == 63) ((float*)(P.ws + WS_GL))[ch] = __expf(g);
    }
    LDS_BARRIER();
    {
        const float Glast = Gs[63];
        float Gr[4], ber[4];
#pragma unroll
        for (int i = 0; i < 4; ++i) { Gr[i] = Gs[r0 + i]; ber[i] = Bes[r0 + i]; }
        float val[3][4][4];
#pragma unroll
        for (int X = 0; X < 3; ++X) {
            const int chX = 1024 * X + h * 128 + d4;
            f32x4 wt[4];
#pragma unroll
            for (int j = 0; j < 4; ++j) wt[j] = *(const f32x4*)(P.w_short + j * 3072 + chX);
            f32x4 xin[7];
#pragma unroll
            for (int j = 0; j < 7; ++j) xin[j] = (f32x4){bf_lo(raw[X][j].x), bf_hi(raw[X][j].x), bf_lo(raw[X][j].y), bf_hi(raw[X][j].y)};
#pragma unroll
            for (int i = 0; i < 4; ++i) {
                f32x4 s = wt[0] * xin[i] + wt[1] * xin[i + 1] + wt[2] * xin[i + 2] + wt[3] * xin[i + 3];
#pragma unroll
                for (int e = 0; e < 4; ++e) val[X][i][e] = fast_silu(s[e]);
            }
        }
        {
            float ss[8];
#pragma unroll
            for (int v = 0; v < 8; ++v) { const int X = v >> 2, i = v & 3;
                ss[v] = (val[X][i][0] * val[X][i][0] + val[X][i][1] * val[X][i][1]) + (val[X][i][2] * val[X][i][2] + val[X][i][3] * val[X][i][3]); }
#pragma unroll
            for (int o = 1; o < 32; o <<= 1) {
                float t[8];
#pragma unroll
                for (int v = 0; v < 8; ++v) t[v] = __shfl_xor(ss[v], o);
#pragma unroll
                for (int v = 0; v < 8; ++v) ss[v] += t[v];
            }
#pragma unroll
            for (int v = 0; v < 8; ++v) { const int X = v >> 2, i = v & 3;
                const float sc = __builtin_amdgcn_rsqf(ss[v] + 1e-6f) * (X == 0 ? 0.08838834764831845f : 1.f);
#pragma unroll
                for (int e = 0; e < 4; ++e) val[X][i][e] *= sc; }
        }
        const int kb = d4 >> 5, hi = (d4 >> 4) & 1, fqd = (d4 >> 2) & 3;
#pragma unroll
        for (int i = 0; i < 4; ++i) {
            const int r = r0 + i;
            u32x2 w;
            w.x = cvt_pk_bf16(val[1][i][0], val[1][i][1]); w.y = cvt_pk_bf16(val[1][i][2], val[1][i][3]);
            *(LAS u32x2*)(lds + PL_KH + r * KH_STRIDE + d4 * 2) = w;
            w.x = cvt_pk_bf16(val[0][i][0], val[0][i][1]); w.y = cvt_pk_bf16(val[0][i][2], val[0][i][3]);
            *(LAS u32x2*)(lds + PL_QH + r * KH_STRIDE + d4 * 2) = w;
            const float be = ber[i], beg = be * __expf(Gr[i]);
            *(LAS f32x4*)(RHS + r * 256 + d4) = (f32x4){val[2][i][0] * be, val[2][i][1] * be, val[2][i][2] * be, val[2][i][3] * be};
            *(LAS f32x4*)(RHS + r * 256 + 128 + d4) = (f32x4){val[1][i][0] * beg, val[1][i][1] * beg, val[1][i][2] * beg, val[1][i][3] * beg};
            const float eg = __expf(Gr[i]);
            w.x = cvt_pk_bf16(val[0][i][0] * eg, val[0][i][1] * eg); w.y = cvt_pk_bf16(val[0][i][2] * eg, val[0][i][3] * eg);
            const int mt = r >> 4, fr = r & 15;
            *(u32x2*)(ops + OPS_Q + ((mt * 4 + kb) * 64 + fqd * 16 + fr) * 16 + hi * 8) = w;
        }
        float ek[4];
#pragma unroll
        for (int i = 0; i < 4; ++i) ek[i] = __expf(Glast - Gr[i]);
        const int kb2 = r0 >> 5, hi2 = (r0 >> 4) & 1, fq2 = (r0 >> 2) & 3;
#pragma unroll
        for (int e = 0; e < 4; ++e) {
            const int d = d4 + e, dt = d >> 4, fr2 = d & 15;
            u32x2 w; w.x = cvt_pk_bf16(val[1][0][e] * ek[0], val[1][1][e] * ek[1]); w.y = cvt_pk_bf16(val[1][2][e] * ek[2], val[1][3][e] * ek[3]);
            *(u32x2*)(ops + OPS_KT + ((dt * 2 + kb2) * 64 + fq2 * 16 + fr2) * 16 + hi2 * 8) = w;
        }
    }
    LDS_BARRIER();
    {
        const int fr = lane & 15, fq = lane >> 4;
        for (int job = wid; job < 26; job += 8) {
            int ct, st; bool isL;
            if (job < 10) { isL = true; int j = job; ct = 0; while (j > ct) { j -= ct + 1; ++ct; } st = j; }
            else { isL = false; const int j = job - 10; ct = j >> 2; st = j & 3; }
            if (isL) {
                f32x4 acc = (f32x4){0.f, 0.f, 0.f, 0.f};
                bf16x8 fa[4], fbb[4];
#pragma unroll
                for (int kb = 0; kb < 4; ++kb) { fa[kb] = *(const LAS bf16x8*)(lds + PL_KH + (16 * ct + fr) * KH_STRIDE + kb * 64 + fq * 16);
                    fbb[kb] = *(const LAS bf16x8*)(lds + PL_KH + (16 * st + fr) * KH_STRIDE + kb * 64 + fq * 16); }
                __builtin_amdgcn_sched_barrier(0);
#pragma unroll
                for (int kb = 0; kb < 4; ++kb) acc = __builtin_amdgcn_mfma_f32_16x16x32_bf16(fa[kb], fbb[kb], acc, 0, 0, 0);
                const int s = 16 * st + fr; const float Gsv = Gs[s];
#pragma unroll
                for (int j = 0; j < 4; ++j) { const int c = 16 * ct + 4 * fq + j;
                    const float v = (c > s) ? Bes[c] * acc[j] * __expf(Gs[c] - Gsv) : 0.f;
                    LM[c * LM_STRIDE + s] = v; }
            } else {
                u32x2 w; w.x = 0u; w.y = 0u;
                if (ct >= st) {
                    f32x4 acc = (f32x4){0.f, 0.f, 0.f, 0.f};
                    bf16x8 fa[4], fbb[4];
#pragma unroll
                    for (int kb = 0; kb < 4; ++kb) { fa[kb] = *(const LAS bf16x8*)(lds + PL_KH + (16 * st + fr) * KH_STRIDE + kb * 64 + fq * 16);
                        fbb[kb] = *(const LAS bf16x8*)(lds + PL_QH + (16 * ct + fr) * KH_STRIDE + kb * 64 + fq * 16); }
                    __builtin_amdgcn_sched_barrier(0);
#pragma unroll
                    for (int kb = 0; kb < 4; ++kb) acc = __builtin_amdgcn_mfma_f32_16x16x32_bf16(fa[kb], fbb[kb], acc, 0, 0, 0);
                    const int c = 16 * ct + fr; const float Gc = Gs[c];
                    float v[4];
#pragma unroll
                    for (int j = 0; j < 4; ++j) { const int s = 16 * st + 4 * fq + j; v[j] = (c >= s) ? acc[j] * __expf(Gc - Gs[s]) : 0.f; }
                    w.x = cvt_pk_bf16(v[0], v[1]); w.y = cvt_pk_bf16(v[2], v[3]);
                }
                *(u32x2*)(ops + OPS_A + ((ct * 2 + (st >> 1)) * 64 + fq * 16 + fr) * 16 + (st & 1) * 8) = w;
            }
        }
    }
    LDS_BARRIER();
    if (tid < 256) {
        LAS float* lmb = LM; asm volatile("" : "+v"(lmb));
        LAS float* rhb = RHS + tid;
        float sol[64];
        f32x4 lb[2][16];
        float rv[2];
        rv[0] = rhb[0];
#pragma unroll
        for (int c = 0; c < 64; ++c) {
            if (c + 1 < 64) {
                rv[(c + 1) & 1] = rhb[(c + 1) * 256];
#pragma unroll
                for (int s4 = 0; s4 < (c + 4) / 4; ++s4) lb[(c + 1) & 1][s4] = *(const LAS f32x4*)(lmb + (c + 1) * LM_STRIDE + 4 * s4);
            }
            float xq[4] = {rv[c & 1], 0.f, 0.f, 0.f};
#pragma unroll
            for (int s4 = 0; s4 < (c + 3) / 4; ++s4) {
                const f32x4 l = lb[c & 1][s4];
#pragma unroll
                for (int e = 0; e < 4; ++e) if (4 * s4 + e < c) xq[e] -= l[e] * sol[4 * s4 + e];
            }
            sol[c] = (xq[0] + xq[1]) + (xq[2] + xq[3]);
        }
#pragma unroll
        for (int c = 0; c < 64; ++c) rhb[c * 256] = sol[c];
    }
    LDS_BARRIER();
#pragma unroll
    for (int i = 0; i < 2; ++i) {
        const int item = tid + 512 * i, f = item >> 6, ln = item & 63, fr = ln & 15, fq = ln >> 4, mt = f >> 2, kb = f & 3;
        const int c = 16 * mt + fr, dk = 32 * kb + 4 * fq;
        const f32x4 a = *(const LAS f32x4*)(RHS + c * 256 + 128 + dk), bb = *(const LAS f32x4*)(RHS + c * 256 + 128 + dk + 16);
        u32x4 w; w.x = cvt_pk_bf16(-a.x, -a.y); w.y = cvt_pk_bf16(-a.z, -a.w); w.z = cvt_pk_bf16(-bb.x, -bb.y); w.w = cvt_pk_bf16(-bb.z, -bb.w);
        *(u32x4*)(ops + OPS_W + item * 16) = w;
    }
#pragma unroll
    for (int i = 0; i < 2; ++i) {
        const int item = tid + 512 * i, f = item >> 6, ln = item & 63, fr = ln & 15, fq = ln >> 4, ds = f >> 1, mp = f & 1;
        float v[8];
#pragma unroll
        for (int j = 0; j < 4; ++j) { v[j] = RHS[(32 * mp + 4 * fq + j) * 256 + 16 * ds + fr]; v[4 + j] = RHS[(32 * mp + 16 + 4 * fq + j) * 256 + 16 * ds + fr]; }
        u32x4 w; w.x = cvt_pk_bf16(v[0], v[1]); w.y = cvt_pk_bf16(v[2], v[3]); w.z = cvt_pk_bf16(v[4], v[5]); w.w = cvt_pk_bf16(v[6], v[7]);
        *(u32x4*)(ops + OPS_U + item * 16) = w;
    }
    LDS_BARRIER();
}

__device__ __forceinline__ void scan_issue(LAS unsigned char* buf, const unsigned char* ops, int lane) {
#pragma unroll
    for (int f = 0; f < 56; ++f)
        __builtin_amdgcn_global_load_lds((const unsigned*)(ops + f * 1024 + lane * 16), (LAS unsigned*)(buf + f * 1024), 16, 0, 0);
}
__device__ __forceinline__ bf16x8 pack8(const f32x4 a, const f32x4 b) {
    u32x4 w; w.x = cvt_pk_bf16(a[0], a[1]); w.y = cvt_pk_bf16(a[2], a[3]); w.z = cvt_pk_bf16(b[0], b[1]); w.w = cvt_pk_bf16(b[2], b[3]);
    return __builtin_bit_cast(bf16x8, w);
}
__device__ __forceinline__ void scan_chain(const Params& P, LAS unsigned char* lds, int chain) {
    const int lane = threadIdx.x & 63, fr = lane & 15, fq = lane >> 4;
    const int xcd = chain & 7, idx = chain >> 3, ds = idx & 7, bh = xcd + 8 * (idx >> 3), b = bh >> 3, h = bh & 7;
    const unsigned char* ops0 = P.ws + WS_SCAN + (size_t)(bh * 64) * OPS_BYTES;
    bf16_t* O = (bf16_t*)(P.ws + WS_O);
    LAS float* OT = (LAS float*)(lds + 2 * 57344);
    float glall = ((const float*)(P.ws + WS_GL))[bh * 64 + lane];
    f32x4 S[8]; bf16x8 Sb[4];
#pragma unroll
    for (int i = 0; i < 8; ++i) S[i] = (f32x4){0.f, 0.f, 0.f, 0.f};
#pragma unroll
    for (int i = 0; i < 4; ++i) Sb[i] = (bf16x8){0, 0, 0, 0, 0, 0, 0, 0};
    scan_issue(lds, ops0, lane);
    u32x4 Un[2];
    Un[0] = *(const u32x4*)(ops0 + OPS_U + ((ds * 2 + 0) * 64 + lane) * 16); Un[1] = *(const u32x4*)(ops0 + OPS_U + ((ds * 2 + 1) * 64 + lane) * 16);
    for (int n = 0; n < 64; ++n) {
        asm volatile("s_waitcnt vmcnt(0)" ::: "memory");
        __builtin_amdgcn_sched_barrier(0);
        asm volatile("" : "+v"(Un[0]), "+v"(Un[1]), "+v"(glall));
        const u32x4 U0 = Un[0], U1 = Un[1];
        const float egl = __builtin_bit_cast(float, __builtin_amdgcn_readlane(__builtin_bit_cast(int, glall), n));
        LAS unsigned char* buf = lds + (n & 1) * 57344;
        if (n + 1 < 64) {
            const unsigned char* opn = ops0 + (size_t)(n + 1) * OPS_BYTES;
            scan_issue(lds + ((n + 1) & 1) * 57344, opn, lane);
            Un[0] = *(const u32x4*)(opn + OPS_U + ((ds * 2 + 0) * 64 + lane) * 16); Un[1] = *(const u32x4*)(opn + OPS_U + ((ds * 2 + 1) * 64 + lane) * 16);
        }
        __builtin_amdgcn_sched_barrier(0);
#define SC_LD(dst, base, idx) dst = *(const LAS bf16x8*)(buf + (base) + ((idx) * 64 + lane) * 16)
#define SC_SB __builtin_amdgcn_sched_barrier(0)
        bf16x8 fa[8], fb[8];
        f32x4 vn[4], o[4];
        vn[0] = (f32x4){bf_lo(U0.x), bf_hi(U0.x), bf_lo(U0.y), bf_hi(U0.y)}; vn[1] = (f32x4){bf_lo(U0.z), bf_hi(U0.z), bf_lo(U0.w), bf_hi(U0.w)};
        vn[2] = (f32x4){bf_lo(U1.x), bf_hi(U1.x), bf_lo(U1.y), bf_hi(U1.y)}; vn[3] = (f32x4){bf_lo(U1.z), bf_hi(U1.z), bf_lo(U1.w), bf_hi(U1.w)};
#pragma unroll
        for (int mt = 0; mt < 4; ++mt) o[mt] = (f32x4){0.f, 0.f, 0.f, 0.f};
#pragma unroll
        for (int mt = 0; mt < 4; ++mt) { SC_LD(fa[mt * 2 + 0], OPS_W, mt * 4 + 0); SC_LD(fa[mt * 2 + 1], OPS_W, mt * 4 + 1); }
        SC_SB;
#pragma unroll
        for (int mt = 0; mt < 4; ++mt) { SC_LD(fb[mt * 2 + 0], OPS_W, mt * 4 + 2); SC_LD(fb[mt * 2 + 1], OPS_W, mt * 4 + 3); }
        SC_SB;
#pragma unroll
        for (int k = 0; k < 2; ++k)
#pragma unroll
            for (int mt = 0; mt < 4; ++mt) vn[mt] = __builtin_amdgcn_mfma_f32_16x16x32_bf16(fa[mt * 2 + k], Sb[k], vn[mt], 0, 0, 0);
        SC_SB;
#pragma unroll
        for (int mt = 0; mt < 4; ++mt) { SC_LD(fa[mt * 2 + 0], OPS_Q, mt * 4 + 0); SC_LD(fa[mt * 2 + 1], OPS_Q, mt * 4 + 1); }
        SC_SB;
#pragma unroll
        for (int k = 0; k < 2; ++k)
#pragma unroll
            for (int mt = 0; mt < 4; ++mt) vn[mt] = __builtin_amdgcn_mfma_f32_16x16x32_bf16(fb[mt * 2 + k], Sb[2 + k], vn[mt], 0, 0, 0);
        bf16x8 vb[2]; vb[0] = pack8(vn[0], vn[1]); vb[1] = pack8(vn[2], vn[3]);
        SC_SB;
#pragma unroll
        for (int mt = 0; mt < 4; ++mt) { SC_LD(fb[mt * 2 + 0], OPS_Q, mt * 4 + 2); SC_LD(fb[mt * 2 + 1], OPS_Q, mt * 4 + 3); }
        SC_SB;
#pragma unroll
        for (int k = 0; k < 2; ++k)
#pragma unroll
            for (int mt = 0; mt < 4; ++mt) o[mt] = __builtin_amdgcn_mfma_f32_16x16x32_bf16(fa[mt * 2 + k], Sb[k], o[mt], 0, 0, 0);
        SC_SB;
#pragma unroll
        for (int i = 0; i < 8; ++i) SC_LD(fa[i], OPS_A, i);
        SC_SB;
#pragma unroll
        for (int k = 0; k < 2; ++k)
#pragma unroll
            for (int mt = 0; mt < 4; ++mt) o[mt] = __builtin_amdgcn_mfma_f32_16x16x32_bf16(fb[mt * 2 + k], Sb[2 + k], o[mt], 0, 0, 0);
        SC_SB;
#pragma unroll
        for (int i = 0; i < 8; ++i) SC_LD(fb[i], OPS_KT, i);
        SC_SB;
#pragma unroll
        for (int k2 = 0; k2 < 2; ++k2)
#pragma unroll
            for (int mt = 0; mt < 4; ++mt) o[mt] = __builtin_amdgcn_mfma_f32_16x16x32_bf16(fa[mt * 2 + k2], vb[k2], o[mt], 0, 0, 0);
        SC_SB;
#pragma unroll
        for (int i = 0; i < 8; ++i) SC_LD(fa[i], OPS_KT, 8 + i);
        SC_SB;
        {
#pragma unroll
            for (int mt = 0; mt < 4; ++mt)
#pragma unroll
                for (int j = 0; j < 4; ++j) OT[(16 * mt + 4 * fq + j) * 20 + fr] = o[mt][j];
            bf16_t* op = O + ((size_t)b * SEQ + n * 64 + (lane >> 2)) * 1024 + h * 128 + ds * 16 + (lane & 3) * 4;
#pragma unroll
            for (int i = 0; i < 4; ++i) { const f32x4 v = *(const LAS f32x4*)(OT + (16 * i + (lane >> 2)) * 20 + (lane & 3) * 4);
                u32x2 w; w.x = cvt_pk_bf16(v[0], v[1]); w.y = cvt_pk_bf16(v[2], v[3]); *(u32x2*)(op + (size_t)(16 * i) * 1024) = w; }
        }
        SC_SB;
#pragma unroll
        for (int dt = 0; dt < 8; ++dt) S[dt] *= egl;
#pragma unroll
        for (int k2 = 0; k2 < 2; ++k2)
#pragma unroll
            for (int dt = 0; dt < 4; ++dt) S[dt] = __builtin_amdgcn_mfma_f32_16x16x32_bf16(fb[dt * 2 + k2], vb[k2], S[dt], 0, 0, 0);
        SC_SB;
#pragma unroll
        for (int k2 = 0; k2 < 2; ++k2)
#pragma unroll
            for (int dt = 0; dt < 4; ++dt) S[4 + dt] = __builtin_amdgcn_mfma_f32_16x16x32_bf16(fa[dt * 2 + k2], vb[k2], S[4 + dt], 0, 0, 0);
        SC_SB;
#undef SC_LD
#undef SC_SB
#pragma unroll
        for (int kb = 0; kb < 4; ++kb) Sb[kb] = pack8(S[2 * kb], S[2 * kb + 1]);
        __builtin_amdgcn_sched_barrier(0);
        asm volatile("s_waitcnt lgkmcnt(0)" ::: "memory");
    }
    asm volatile("s_waitcnt vmcnt(0)" ::: "memory");
}

struct WcItem { const float* src; bf16_t* dst; int N, Kd; };
constexpr int NWL_FFN = 3 * 5632;
constexpr int SC_CONV = 2 * 57344 + 5120;
constexpr int SC_CONV_WAVE = 8704;
__device__ __forceinline__ WcItem wc_item(const Params& P, int i, const float* wg, const float* wu, const float* wd) {
    bf16_t* WUP = (bf16_t*)(P.ws + WS_WUP); bf16_t* WDN = (bf16_t*)(P.ws + WS_WDN);
    WcItem it;
    if (i < 11264) { const int up = i >= 5632; if (up) i -= 5632; const int k0 = (i / 176) * 64, n0 = (i % 176) * 32;
        it.src = (up ? wu : wg) + (size_t)k0 * DFF + n0; it.N = DFF; it.Kd = DM; it.dst = WUP + (size_t)(256 * (n0 >> 7) + (n0 & 127) + (up ? 128 : 0)) * DM + k0; }
    else { i -= 11264; const int k0 = (i / 64) * 64, n0 = (i % 64) * 32; it.src = wd + (size_t)k0 * DM + n0; it.N = DM; it.Kd = DFF; it.dst = WDN + (size_t)n0 * DFF + k0; }
    return it;
}
__device__ __forceinline__ void wc_load(const WcItem& it, f32x4 (&v)[8], int lane) {
    const int r = lane >> 3, c4 = (lane & 7) * 4;
#pragma unroll
    for (int i = 0; i < 8; ++i) v[i] = __builtin_nontemporal_load((const f32x4*)(it.src + (size_t)(8 * i + r) * it.N + c4));
}
__device__ __forceinline__ void wc_store(const WcItem& it, const f32x4 (&v)[8], LAS float* scr, int lane) {
    const int r = lane >> 3, c4 = (lane & 7) * 4;
#pragma unroll
    for (int i = 0; i < 8; ++i) { LAS float* d = scr + (8 * i + r) * 34 + c4; *(LAS f32x2*)d = (f32x2){v[i][0], v[i][1]}; *(LAS f32x2*)(d + 2) = (f32x2){v[i][2], v[i][3]}; }
    asm volatile("s_waitcnt lgkmcnt(0)" ::: "memory");
#pragma unroll
    for (int j = 0; j < 4; ++j) {
        const int o = lane + 64 * j, kg = o & 7, n = o >> 3;
        float f[8];
#pragma unroll
        for (int t = 0; t < 8; ++t) f[t] = scr[(8 * kg + t) * 34 + n];
        u32x4 w; w.x = cvt_pk_bf16(f[0], f[1]); w.y = cvt_pk_bf16(f[2], f[3]); w.z = cvt_pk_bf16(f[4], f[5]); w.w = cvt_pk_bf16(f[6], f[7]);
        *(u32x4*)(it.dst + (size_t)n * it.Kd + 8 * kg) = w;
    }
    asm volatile("s_waitcnt lgkmcnt(0)" ::: "memory");
}
__device__ __forceinline__ void wc_wave_loop(const Params& P, const float* wg, const float* wu, const float* wd, LAS float* scr, int gw, int NW, int lane) {
    int i0 = gw;
    if (i0 >= NWL_FFN) return;
    WcItem A = wc_item(P, i0, wg, wu, wd), B = A; bool hasB = (i0 + NW) < NWL_FFN;
    if (hasB) B = wc_item(P, i0 + NW, wg, wu, wd);
    f32x4 va[8], vb[8];
#pragma unroll
    for (int i = 0; i < 8; ++i) vb[i] = (f32x4){0.f, 0.f, 0.f, 0.f};
    wc_load(A, va, lane); if (hasB) wc_load(B, vb, lane);
    for (;;) {
        const WcItem cA = A, cB = B; const bool cHasB = hasB;
        f32x4 ca[8], cb[8];
#pragma unroll
        for (int i = 0; i < 8; ++i) { ca[i] = va[i]; cb[i] = vb[i]; }
        i0 += 2 * NW;
        const bool more = i0 < NWL_FFN;
        if (more) { A = wc_item(P, i0, wg, wu, wd); hasB = (i0 + NW) < NWL_FFN; if (hasB) B = wc_item(P, i0 + NW, wg, wu, wd);
            wc_load(A, va, lane); if (hasB) wc_load(B, vb, lane); }
        wc_store(cA, ca, scr, lane);
        if (cHasB) wc_store(cB, cb, scr, lane);
        if (!more) break;
    }
}

__device__ __forceinline__ void dn_out_phase(const Params& P) {
    const bf16_t* O = (const bf16_t*)(P.ws + WS_O); const bf16_t* PB = (const bf16_t*)(P.ws + WS_BIG); bf16_t* Y = (bf16_t*)(P.ws + WS_H);
    const int lane = threadIdx.x & 63, wid = threadIdx.x >> 6;
    const int d0 = (lane & 7) * 16;
    float nw[16];
#pragma unroll
    for (int i = 0; i < 16; ++i) nw[i] = P.dn_norm_w[d0 + i];
    const int NW = gridDim.x * 8;
    for (int row0 = blockIdx.x * 8 + wid; row0 < T_TOK; row0 += 2 * NW) {
        f32x4 v[2][4]; u32x4 z[2][2];
#pragma unroll
        for (int r = 0; r < 2; ++r) { const int row = (row0 + r * NW < T_TOK) ? row0 + r * NW : row0;
            const u32x4* op = (const u32x4*)(O + (size_t)row * 1024 + lane * 16);
            const u32x4* zp = (const u32x4*)(PB + (size_t)row * NIN + 5120 + lane * 16);
            const u32x4 q0 = op[0], q1 = op[1];
            v[r][0] = (f32x4){bf_lo(q0.x), bf_hi(q0.x), bf_lo(q0.y), bf_hi(q0.y)}; v[r][1] = (f32x4){bf_lo(q0.z), bf_hi(q0.z), bf_lo(q0.w), bf_hi(q0.w)};
            v[r][2] = (f32x4){bf_lo(q1.x), bf_hi(q1.x), bf_lo(q1.y), bf_hi(q1.y)}; v[r][3] = (f32x4){bf_lo(q1.z), bf_hi(q1.z), bf_lo(q1.w), bf_hi(q1.w)};
            z[r][0] = zp[0]; z[r][1] = zp[1]; }
#pragma unroll
        for (int r = 0; r < 2; ++r) {
            const int row = row0 + r * NW;
            if (row < T_TOK) {
                float ss = 0.f;
#pragma unroll
                for (int i = 0; i < 4; ++i) ss += (v[r][i].x * v[r][i].x + v[r][i].y * v[r][i].y) + (v[r][i].z * v[r][i].z + v[r][i].w * v[r][i].w);
                ss += __shfl_xor(ss, 1); ss += __shfl_xor(ss, 2); ss += __shfl_xor(ss, 4);
                const float rstd = 1.f / sqrtf(ss * (1.f / 128.f) + 1e-6f);
                const unsigned zz[8] = {z[r][0].x, z[r][0].y, z[r][0].z, z[r][0].w, z[r][1].x, z[r][1].y, z[r][1].z, z[r][1].w};
                unsigned w[8];
#pragma unroll
                for (int i = 0; i < 8; ++i) {
                    const float a = v[r][i >> 1][(i & 1) * 2] * rstd * nw[2 * i] * fast_silu(bf_lo(zz[i]));
                    const float bq = v[r][i >> 1][(i & 1) * 2 + 1] * rstd * nw[2 * i + 1] * fast_silu(bf_hi(zz[i]));
                    w[i] = cvt_pk_bf16(a, bq);
                }
                u32x4* yp = (u32x4*)(Y + (size_t)row * DM + 1024 + lane * 16);
                yp[0] = (u32x4){w[0], w[1], w[2], w[3]}; yp[1] = (u32x4){w[4], w[5], w[6], w[7]};
            }
        }
    }
}

__device__ __forceinline__ void final_norm_phase(const Params& P) {
    const bf16_t* X3 = (const bf16_t*)(P.ws + WS_H);
    const int lane = threadIdx.x & 63, wid = threadIdx.x >> 6;
    const int NW = gridDim.x * 8;
    for (int row = blockIdx.x * 8 + wid; row < T_TOK; row += 2 * NW) {
        const int row1 = row + NW; const bool two = row1 < T_TOK;
        const u32x2* xr0 = (const u32x2*)(X3 + (size_t)row * DM) + lane; const u32x2* xr1 = (const u32x2*)(X3 + (size_t)(two ? row1 : row) * DM) + lane;
        u32x2 r0[8], r1[8];
#pragma unroll
        for (int i = 0; i < 8; ++i) { r0[i] = xr0[64 * i]; r1[i] = xr1[64 * i]; }
        f32x4 v0[8], v1[8]; float ss0 = 0.f, ss1 = 0.f;
#pragma unroll
        for (int i = 0; i < 8; ++i) { v0[i] = (f32x4){bf_lo(r0[i].x), bf_hi(r0[i].x), bf_lo(r0[i].y), bf_hi(r0[i].y)}; v1[i] = (f32x4){bf_lo(r1[i].x), bf_hi(r1[i].x), bf_lo(r1[i].y), bf_hi(r1[i].y)};
            ss0 += (v0[i].x * v0[i].x + v0[i].y * v0[i].y) + (v0[i].z * v0[i].z + v0[i].w * v0[i].w);
            ss1 += (v1[i].x * v1[i].x + v1[i].y * v1[i].y) + (v1[i].z * v1[i].z + v1[i].w * v1[i].w); }
#pragma unroll
        for (int o = 1; o < 64; o <<= 1) { const float t0 = __shfl_xor(ss0, o), t1 = __shfl_xor(ss1, o); ss0 += t0; ss1 += t1; }
        const float rstd0 = 1.f / sqrtf(ss0 * (1.f / DM) + 1e-6f), rstd1 = 1.f / sqrtf(ss1 * (1.f / DM) + 1e-6f);
        f32x4* o0 = (f32x4*)(P.out + (size_t)row * DM) + lane; f32x4* o1 = (f32x4*)(P.out + (size_t)(two ? row1 : row) * DM) + lane;
#pragma unroll
        for (int i = 0; i < 8; ++i) { const f32x4 w = *((const f32x4*)P.final_norm + lane + 64 * i); __builtin_nontemporal_store(v0[i] * rstd0 * w, o0 + 64 * i); if (two) __builtin_nontemporal_store(v1[i] * rstd1 * w, o1 + 64 * i); }
    }
}

#define XB_TMO      128
#define XB_XCNT(j)  (256  + 64 * (j))
#define XB_XSUB(j)  (1280 + 64 * (j))
#define XB_XGEN(j)  (2304 + 64 * (j))
#define XB_TOP      3328
#define XB_TOPGEN   3392
#define XCD_BAR_WORDS 3456
#define XB_SPIN_CAP (1u << 22)
__device__ __forceinline__ unsigned xb_ld(unsigned* p)              { return __hip_atomic_load(p, __ATOMIC_RELAXED, __HIP_MEMORY_SCOPE_AGENT); }
__device__ __forceinline__ unsigned xb_add(unsigned* p, unsigned v) { return __hip_atomic_fetch_add(p, v, __ATOMIC_RELAXED, __HIP_MEMORY_SCOPE_AGENT); }
__device__ __forceinline__ unsigned xb_xcc_id() { return (unsigned)__builtin_amdgcn_s_getreg((3 << 11) | 20) & 0xFu; }
#define XB_SPIN(cond, bar) do { unsigned _sp = 0; while (cond) { __builtin_amdgcn_s_sleep(1); \
    if ((++_sp & 255u) == 0u) { if (xb_ld(&(bar)[XB_TMO])) break; if (_sp > XB_SPIN_CAP) { atomicAdd(&(bar)[XB_TMO], 1u); break; } } } } while (0)
struct XcdBarrier { unsigned* bar; unsigned x; volatile LAS unsigned* st; };
__device__ __forceinline__ XcdBarrier xcd_barrier_post(unsigned* bar, volatile LAS unsigned* st) {
    XcdBarrier b; b.bar = bar; b.x = xb_xcc_id(); b.st = st;
    if (threadIdx.x == 0) (void)xb_add(&bar[XB_XCNT(b.x)], 1u);
    return b;
}
__device__ __forceinline__ void xcd_barrier_complete(unsigned* bar, unsigned x, unsigned& nloc, unsigned& nx) {
    const unsigned G = gridDim.x * gridDim.y * gridDim.z;
    unsigned sum, cnt, mine, sp = 0u;
    for (;;) {
        sum = 0u; cnt = 0u; mine = 0u;
#pragma unroll
        for (unsigned j = 0; j < 16; ++j) { const unsigned c = xb_ld(&bar[XB_XCNT(j)]); sum += c; cnt += (c > 0u) ? 1u : 0u; mine = (j == x) ? c : mine; }
        if (sum == G) break;
        __builtin_amdgcn_s_sleep(1);
        if ((++sp & 255u) == 0u) { if (xb_ld(&bar[XB_TMO])) break; if (sp > XB_SPIN_CAP) { atomicAdd(&bar[XB_TMO], 1u); break; } }
    }
    nloc = mine > 0u ? mine : 1u; nx = cnt > 0u ? cnt : 1u;
}
__device__ __forceinline__ void xcd_barrier(const XcdBarrier& b) {
    asm volatile("s_waitcnt vmcnt(0)" ::: "memory");
    __syncthreads();
    if (threadIdx.x == 0) {
        unsigned* bar = b.bar;
        __builtin_amdgcn_s_waitcnt(0);
        unsigned nloc = b.st[0], nx = b.st[1];
        if (nloc == 0u) { xcd_barrier_complete(bar, b.x, nloc, nx); b.st[0] = nloc; b.st[1] = nx; }
        const unsigned old = xb_add(&bar[XB_XSUB(b.x)], 1u);
        const unsigned gen = old / nloc;
        if (old + 1u == (gen + 1u) * nloc) {
            __builtin_amdgcn_fence(__ATOMIC_RELEASE, "agent");
            asm volatile("s_waitcnt vmcnt(0)" ::: "memory");
            const unsigned og = xb_add(&bar[XB_TOP], 1u);
            const unsigned tg = og / nx;
            if (og + 1u == (tg + 1u) * nx) xb_add(&bar[XB_TOPGEN], 1u);
            else XB_SPIN(xb_ld(&bar[XB_TOPGEN]) == tg, bar);
            __builtin_amdgcn_fence(__ATOMIC_ACQUIRE, "agent");
            xb_add(&bar[XB_XGEN(b.x)], 1u);
            asm volatile("s_waitcnt vmcnt(0)" ::: "memory");
        } else {
            XB_SPIN(xb_ld(&bar[XB_XGEN(b.x)]) == gen, bar);
            __builtin_amdgcn_fence(__ATOMIC_ACQUIRE, "agent");
            asm volatile("s_waitcnt vmcnt(0)" ::: "memory");
        }
    }
    __syncthreads();
}

constexpr int N_PHASES = 14;
#ifdef ONLY_PH
#define PH_ON(k) ((k) == ONLY_PH)
#else
#define PH_ON(k) 1
#endif
__global__ void __launch_bounds__(512, 2) fwd_megakernel(Params P) {
    extern __shared__ __attribute__((aligned(16))) unsigned char lds_raw[];
    LAS unsigned char* lds = (LAS unsigned char*)lds_raw;
    const int G = gridDim.x;
    bf16_t* H = (bf16_t*)(P.ws + WS_H); bf16_t* BIG = (bf16_t*)(P.ws + WS_BIG);
    bf16_t* XB2 = (bf16_t*)(P.ws + WS_SCAN);
    float* ROWSS = (float*)(P.ws + WS_MODP); unsigned* PCNT = (unsigned*)(P.ws + WS_BAR) + 3584;
    bf16_t* XB = (bf16_t*)P.out;
    const bf16_t* WUP = (const bf16_t*)(P.ws + WS_WUP); const bf16_t* WDN = (const bf16_t*)(P.ws + WS_WDN);
    const bf16_t* WIN = (const bf16_t*)(P.ws + WS_WIN); const bf16_t* WOUT = (const bf16_t*)(P.ws + WS_WOUT);
    const float* mods = (const float*)(P.ws + WS_MODS);
    const int lo = P.ph_lo, hi = P.ph_hi;
    volatile LAS unsigned* xst = (volatile LAS unsigned*)(lds + LDS_BYTES - 16);
    XcdBarrier xbar; xbar.bar = (unsigned*)(P.ws + WS_BAR); xbar.x = 0; xbar.st = xst;
    if (hi - lo > 1) {
        if (threadIdx.x == 0) { xst[0] = 0u; xst[1] = 0u; }
        __syncthreads();
        xbar = xcd_barrier_post((unsigned*)(P.ws + WS_BAR), xst);
    }
    if (lo < 0) cg::this_grid().sync();
#define IN(k) (PH_ON(k) && lo <= (k) && (k) < hi)
#define SEAM(k) do { if (lo <= (k) && (k) + 1 < hi) { for (int _s = 0; _s < PROBE_SYNC_REP; ++_s) { xcd_barrier(xbar); } } } while (0)
#define REPN(k) for (int _r = 0; _r < (((PROBE_REP_MASK >> (k)) & 1) ? 2 : 1); ++_r)
    if (IN(0)) REPN(0) { phase0(P, lds); }
    SEAM(0);
    if (IN(1)) REPN(1) { mods_finalize(P); norm_mod_phase<false>(P, lds, P.x, P.ffn1_norm, 0, true, H); }
    SEAM(1);
    if (IN(2)) REPN(2) { pg8::Gemm g{H, WUP, T_TOK, NUP, DM}; pg8::StaticOrder S; S.init(T_TOK, NUP, G, blockIdx.x, 8); pg8::EpiSwiGLU E{BIG, DFF}; pg8::gemm_phase(lds, g, S, E); }
    SEAM(2);
    if (IN(3)) REPN(3) { pg8::Gemm g{BIG, WDN, T_TOK, DM, DFF}; pg8::StaticOrder S; S.init(T_TOK, DM, G, blockIdx.x); pg8::EpiResidB<false, true> E{P.x, XB, mods + 2 * DM}; pg8::gemm_phase(lds, g, S, E); }
    SEAM(3);
    if (IN(4)) REPN(4) { for (int i = blockIdx.x * 512 + threadIdx.x; i < T_TOK; i += G * 512) ROWSS[i] = 0.f;
        norm_mod_phase<true>(P, lds, XB, P.mix_norm, 3, false, H); }
    SEAM(4);
    if (IN(5)) REPN(5) { pg8::Gemm g{H, WIN, T_TOK, 6144, DM}; pg8::StaticOrder S; S.init(T_TOK, 6144, G, blockIdx.x); pg8::EpiBf16 E{BIG, NIN}; pg8::gemm_phase(lds, g, S, E); gate_cols_phase(P, lds); }
    SEAM(5);
    if (IN(6)) REPN(6) {
        for (int _p = 0; _p < PROBE_PREP_REP; ++_p) { float gb = 0.f, ga = 0.f; int ch = blockIdx.x;
            if (ch < NCH_TOT) dn_gate_load(P, ch, gb, ga);
            for (; ch < NCH_TOT; ch += G) dn_prep_chunk(P, lds, ch, gb, ga, (ch + G < NCH_TOT) ? ch + G : -1); }
        for (int _p = 0; _p < PROBE_CONV_REP; ++_p) for (int it = blockIdx.x; it < NB * (SEQ / 32); it += G) conv_item(P, lds, it);
    }
    SEAM(6);
    if (IN(7)) REPN(7) {
        const int wv = threadIdx.x >> 6;
        if (wv == 0) { for (int chain = blockIdx.x; chain < 256; chain += G) scan_chain(P, lds, chain); }
        else if (wv >= 3) {
            const int lane = threadIdx.x & 63, gw = blockIdx.x * 5 + (wv - 3), NW = G * 5;
            LAS float* scr = (LAS float*)(lds + SC_CONV + (wv - 3) * SC_CONV_WAVE);
            wc_wave_loop(P, P.ffn2_wg, P.ffn2_wu, P.ffn2_wd, scr, gw, NW, lane);
        }
    }
    SEAM(7);
    if (IN(8)) REPN(8) { dn_out_phase(P); }
    SEAM(8);
    if (IN(9)) { pg8::Gemm g{H, WOUT, T_TOK, DM, DM}; pg8::StaticOrder S; S.init(T_TOK, DM, G, blockIdx.x); pg8::EpiResidB<true, false> E{XB, XB2, mods + 5 * DM}; pg8::gemm_phase(lds, g, S, E); }
    SEAM(9);
    if (IN(10)) REPN(10) { norm_mod_phase<true>(P, lds, XB2, P.ffn2_norm, 6, false, H); }
    SEAM(10);
    if (IN(11)) REPN(11) { pg8::Gemm g{H, WUP, T_TOK, NUP, DM}; pg8::StaticOrder S; S.init(T_TOK, NUP, G, blockIdx.x, 8); pg8::EpiSwiGLU E{BIG, DFF}; pg8::gemm_phase(lds, g, S, E); }
    SEAM(11);
    if (IN(12)) { pg8::Gemm g{BIG, WDN, T_TOK, DM, DFF}; pg8::StaticOrder S; S.init(T_TOK, DM, G, blockIdx.x); pg8::EpiFinal E{XB2, P.out, mods + 8 * DM, P.final_norm, ROWSS, PCNT}; pg8::gemm_phase(lds, g, S, E); }

#undef IN
#undef SEAM
}

extern "C" void kernel_launch(void* const* d_in, const int* in_sizes, int n_in, void* d_out, int out_size, void* d_ws, size_t ws_size, hipStream_t stream) {
    static int grid = 0;
    if (grid == 0) {
        if (n_in != 24 || out_size != T_TOK * DM || ws_size < WS_END) { fprintf(stderr, "kernel_launch: unexpected shapes (n_in %d out %d ws %zu need %zu)\n", n_in, out_size, ws_size, (size_t)WS_END); grid = -1; return; }
        int dev = 0, cus = 0, per_cu = 0;
        hipGetDevice(&dev); hipDeviceGetAttribute(&cus, hipDeviceAttributeMultiprocessorCount, dev);
        if (hipFuncSetAttribute((const void*)fwd_megakernel, hipFuncAttributeMaxDynamicSharedMemorySize, LDS_BYTES) != hipSuccess) { fprintf(stderr, "kernel_launch: hipFuncSetAttribute failed\n"); grid = -1; return; }
        hipOccupancyMaxActiveBlocksPerMultiprocessor(&per_cu, (const void*)fwd_megakernel, 512, LDS_BYTES);
        if (per_cu < 1) { fprintf(stderr, "kernel_launch: occupancy query says %d\n", per_cu); per_cu = 1; }
        (void)hipGetLastError();
        grid = cus;
    }
    if (grid < 0) return;
    Params p{};
    const float** pp = (const float**)&p;
    for (int i = 0; i < 24; ++i) pp[i] = (const float*)d_in[i];
    p.out = (float*)d_out; p.ws = (unsigned char*)d_ws;
    hipMemsetAsync(d_ws, 0, 16384, stream);
#if MK_MULTI
    for (int ph = 0; ph < N_PHASES; ++ph) { p.ph_lo = ph; p.ph_hi = ph + 1; hipLaunchKernelGGL(fwd_megakernel, dim3(grid), dim3(512), LDS_BYTES, stream, p); }
#else
    p.ph_lo = 0; p.ph_hi = N_PHASES;
    void* args[] = {&p};
    hipError_t e = hipLaunchCooperativeKernel((const void*)fwd_megakernel, dim3(grid), dim3(512), args, LDS_BYTES, stream);
    if (e != hipSuccess) fprintf(stderr, "cooperative launch failed: %s (grid %d)\n", hipGetErrorString(e), grid);
#endif
}
```

```cpp
#include <hip/hip_runtime.h>
#include <hip/hip_cooperative_groups.h>
#include <cstdio>
namespace cg = cooperative_groups;

#ifndef MK_MULTI
#define MK_MULTI 0
#endif

#ifndef PROBE_REP_MASK
#define PROBE_REP_MASK 0
#endif
#ifndef PROBE_PREP_REP
#define PROBE_PREP_REP 1
#endif
#ifndef PROBE_CONV_REP
#define PROBE_CONV_REP 1
#endif
#ifndef PROBE_SYNC_REP
#define PROBE_SYNC_REP 1
#endif
#define LAS __attribute__((address_space(3)))
typedef unsigned short bf16_t;
typedef short bf16x8 __attribute__((ext_vector_type(8)));
typedef float f32x4 __attribute__((ext_vector_type(4)));
typedef float f32x2 __attribute__((ext_vector_type(2)));
typedef unsigned u32x4 __attribute__((ext_vector_type(4)));
typedef unsigned u32x2 __attribute__((ext_vector_type(2)));

constexpr int T_TOK = 16384, DM = 2048, DFF = 5632, NUP = 2 * DFF, SEQ = 4096, NB = 4;
constexpr int NIN_REAL = 6160, NIN = 6400, NMOD = 9 * DM;
constexpr int KS_ADA = 8;
constexpr int NCHUNK = 64, NHEAD = 8, NCH_TOT = NB * NHEAD * NCHUNK;
constexpr int OPS_BYTES = 73728;
constexpr int OPS_W = 0, OPS_Q = 16384, OPS_KT = 32768, OPS_A = 49152, OPS_U = 57344;
constexpr int LDS_BYTES = 163840;

constexpr size_t al256(size_t x) { return (x + 255) & ~(size_t)255; }
constexpr size_t WS_BAR = 0;
constexpr size_t WS_MODP = 16384;
constexpr size_t WS_MODS = al256(WS_MODP + (size_t)KS_ADA * NB * NMOD * 4);
constexpr size_t WS_GL   = al256(WS_MODS + (size_t)NB * NMOD * 4);
constexpr size_t WS_WUP  = al256(WS_GL + (size_t)NCH_TOT * 4);
constexpr size_t WS_WDN  = al256(WS_WUP + (size_t)NUP * DM * 2);
constexpr size_t WS_WIN  = al256(WS_WDN + (size_t)DM * DFF * 2);
constexpr size_t WS_WOUT = al256(WS_WIN + (size_t)NIN * DM * 2);
constexpr size_t WS_H    = al256(WS_WOUT + (size_t)DM * DM * 2);
constexpr size_t WS_BIG  = al256(WS_H + (size_t)T_TOK * DM * 2);
constexpr size_t WS_SCAN = al256(WS_BIG + (size_t)T_TOK * NIN * 2);
constexpr size_t WS_O    = al256(WS_SCAN + (size_t)NCH_TOT * OPS_BYTES);
constexpr size_t WS_END  = al256(WS_O + (size_t)T_TOK * 1024 * 4);

struct Params {
    const float *x, *c, *w_ada, *b_ada, *ffn1_norm, *ffn1_wg, *ffn1_wu, *ffn1_wd, *mix_norm, *w_in, *w_dw, *b_dw, *conv_ln_w, *conv_ln_b,
                *w_short, *a_log, *dt_bias, *dn_norm_w, *w_out, *ffn2_norm, *ffn2_wg, *ffn2_wu, *ffn2_wd, *final_norm;
    float* out; unsigned char* ws;
    int ph_lo, ph_hi;
};

typedef __bf16 bf16x2_t __attribute__((ext_vector_type(2)));
__device__ __forceinline__ unsigned cvt_pk_bf16(float lo, float hi) { const f32x2 v = {lo, hi}; const bf16x2_t r = __builtin_convertvector(v, bf16x2_t); return __builtin_bit_cast(unsigned, r); }
__device__ __forceinline__ float bf_lo(unsigned w) { return __uint_as_float(w << 16); }
__device__ __forceinline__ float bf_hi(unsigned w) { return __uint_as_float(w & 0xffff0000u); }
__device__ __forceinline__ float bf1(bf16_t v) { return __uint_as_float(((unsigned)v) << 16); }
__device__ __forceinline__ float wave_sum(float v) {
#pragma unroll
    for (int o = 1; o < 64; o <<= 1) v += __shfl_xor(v, o);
    return v;
}
#define LDS_BARRIER() do { asm volatile("s_waitcnt lgkmcnt(0)" ::: "memory"); __builtin_amdgcn_s_barrier(); asm volatile("" ::: "memory"); } while (0)
__device__ __forceinline__ float fast_sigmoid(float v) { return __builtin_amdgcn_rcpf(1.f + __builtin_amdgcn_exp2f(-1.44269504f * v)); }
__device__ __forceinline__ float fast_silu(float v) { return v * fast_sigmoid(v); }

namespace pg8 {
constexpr int BM = 256, BK = 64, HALF = 128, HTB = HALF * BK * 2, STAGE_BYTES = 8 * HTB, NXCD = 8, WGM = 4;
__host__ __device__ __forceinline__ int lds_byte(int r, int c) { const int st = (r >> 4) * 2 + (c >> 5), rr = r & 15, cc = c & 31, ob = rr * 64 + cc * 2; return st * 1024 + (ob ^ (((ob >> 9) & 1) << 5)); }
__host__ __device__ __forceinline__ void stage_rc(int b, int& R, int& C) { const int st = b / 1024, sb = b % 1024, swz = sb ^ (((sb >> 9) & 1) << 5); R = (st >> 1) * 16 + swz / 64; C = (st & 1) * 32 + (swz % 64) / 2; }
__host__ __device__ __forceinline__ int perm32(int rho) { const int n = rho >> 4, i = rho & 15; return 8 * (i >> 2) + 4 * n + (i & 3); }
struct Unit { int pm, pn; };
struct Gemm { const bf16_t* A; const bf16_t* Bt; int M, N, K; };
struct StaticOrder {
    int nM, nN, nwg, G, c, wgm;
    __host__ __device__ void init(int M, int N, int G_, int c_, int wgm_ = WGM) { nM = M / BM; nN = N / BM; nwg = nM * nN; G = G_; c = c_; wgm = wgm_; }
    __host__ __device__ bool next(int i, Unit& u) const {
        const long L = (long)i * G + c; if (L >= nwg) return false;
        int wgid = (int)L; { const int q = nwg / NXCD, r = nwg % NXCD, xcd = wgid % NXCD, off = wgid / NXCD; wgid = (xcd < r ? xcd * (q + 1) : r * (q + 1) + (xcd - r) * q) + off; }
        const int nig = wgm * nN, gid = wgid / nig, fm = gid * wgm, gsz = (nM - fm) < wgm ? (nM - fm) : wgm;
        u.pm = fm + ((wgid % nig) % gsz); u.pn = (wgid % nig) / gsz; return true;
    }
};

struct EpiSwiGLU {
    static constexpr bool PERM = true;
    bf16_t* O; int ldc;
    __device__ __forceinline__ void operator()(const f32x4 (&acc)[2][2][4][2], const Unit& u, int wr, int wc, int fr, int fq) const {
        const int row0 = u.pm * BM + wr * 64 + fr, col0 = u.pn * HALF + wc * 32 + 8 * fq;
#pragma unroll
        for (int ai = 0; ai < 2; ++ai)
#pragma unroll
            for (int m = 0; m < 4; ++m) {
                bf16_t* rowp = O + (size_t)(row0 + ai * HALF + m * 16) * ldc + col0;
                float v[8];
#pragma unroll
                for (int n = 0; n < 2; ++n)
#pragma unroll
                    for (int j = 0; j < 4; ++j) { const float g = acc[ai][0][m][n][j], uu = acc[ai][1][m][n][j]; v[n * 4 + j] = fast_silu(g) * uu; }
                u32x4 w; w.x = cvt_pk_bf16(v[0], v[1]); w.y = cvt_pk_bf16(v[2], v[3]); w.z = cvt_pk_bf16(v[4], v[5]); w.w = cvt_pk_bf16(v[6], v[7]);
                *(u32x4*)rowp = w;
            }
    }
};
struct EpiResid {
    static constexpr bool PERM = false;
    const float* base; float* out; const float* gate; float gs;
    __device__ __forceinline__ void operator()(const f32x4 (&acc)[2][2][4][2], const Unit& u, int wr, int wc, int fr, int fq) const {
        const int row0 = u.pm * BM + wr * 64 + fr, col0 = u.pn * BM + wc * 32 + 4 * fq, b = u.pm >> 4;
        f32x4 gv[2][2];
#pragma unroll
        for (int bj = 0; bj < 2; ++bj)
#pragma unroll
            for (int n = 0; n < 2; ++n) gv[bj][n] = *(const f32x4*)(gate + (size_t)b * NMOD + col0 + bj * HALF + n * 16) * gs;
#pragma unroll
        for (int ai = 0; ai < 2; ++ai)
#pragma unroll
            for (int m = 0; m < 4; ++m) {
                const size_t off = (size_t)(row0 + ai * HALF + m * 16) * DM + col0;
#pragma unroll
                for (int bj = 0; bj < 2; ++bj)
#pragma unroll
                    for (int n = 0; n < 2; ++n) { const f32x4 bb = *(const f32x4*)(base + off + bj * HALF + n * 16); *(f32x4*)(out + off + bj * HALF + n * 16) = bb + gv[bj][n] * acc[ai][bj][m][n]; }
            }
    }
};
template <bool BASE_BF16, bool HALFG> struct EpiResidB {
    static constexpr bool PERM = false;
    const void* base; bf16_t* out; const float* gate;
    static constexpr float gs = HALFG ? 0.5f : 1.0f;
    __device__ __forceinline__ void operator()(const f32x4 (&acc)[2][2][4][2], const Unit& u, int wr, int wc, int fr, int fq) const {
        const int row0 = u.pm * BM + wr * 64 + fr, col0 = u.pn * BM + wc * 32 + 4 * fq, b = u.pm >> 4;
        f32x4 gv[2][2];
#pragma unroll
        for (int bj = 0; bj < 2; ++bj)
#pragma unroll
            for (int n = 0; n < 2; ++n) gv[bj][n] = *(const f32x4*)(gate + (size_t)b * NMOD + col0 + bj * HALF + n * 16) * gs;
#pragma unroll
        for (int ai = 0; ai < 2; ++ai) {
            f32x4 bb[4][2][2];
#pragma unroll
            for (int m = 0; m < 4; ++m) {
                const size_t off = (size_t)(row0 + ai * HALF + m * 16) * DM + col0;
#pragma unroll
                for (int bj = 0; bj < 2; ++bj)
#pragma unroll
                    for (int n = 0; n < 2; ++n) {
                        if (BASE_BF16) { const u32x2 r = *(const u32x2*)((const bf16_t*)base + off + bj * HALF + n * 16); bb[m][bj][n] = (f32x4){__uint_as_float(r.x), __uint_as_float(r.y), 0.f, 0.f}; }
                        else bb[m][bj][n] = *(const f32x4*)((const float*)base + off + bj * HALF + n * 16);
                    }
            }
            __builtin_amdgcn_sched_barrier(0);
#pragma unroll
            for (int m = 0; m < 4; ++m) {
                const size_t off = (size_t)(row0 + ai * HALF + m * 16) * DM + col0;
#pragma unroll
                for (int bj = 0; bj < 2; ++bj)
#pragma unroll
                    for (int n = 0; n < 2; ++n) {
                        f32x4 x;
                        if (BASE_BF16) { const unsigned r0 = __float_as_uint(bb[m][bj][n][0]), r1 = __float_as_uint(bb[m][bj][n][1]); x = (f32x4){bf_lo(r0), bf_hi(r0), bf_lo(r1), bf_hi(r1)}; }
                        else x = bb[m][bj][n];
                        const f32x4 xn = x + gv[bj][n] * acc[ai][bj][m][n];
                        u32x2 w; w.x = cvt_pk_bf16(xn[0], xn[1]); w.y = cvt_pk_bf16(xn[2], xn[3]);
                        *(u32x2*)(out + off + bj * HALF + n * 16) = w;
                    }
            }
            __builtin_amdgcn_sched_barrier(0);
        }
    }
};
struct EpiBf16 {
    static constexpr bool PERM = true;
    bf16_t* O; int ldc;
    __device__ __forceinline__ void operator()(const f32x4 (&acc)[2][2][4][2], const Unit& u, int wr, int wc, int fr, int fq) const {
        const int row0 = u.pm * BM + wr * 64 + fr, col0 = u.pn * BM + wc * 32 + 8 * fq;
#pragma unroll
        for (int ai = 0; ai < 2; ++ai)
#pragma unroll
            for (int m = 0; m < 4; ++m) {
                bf16_t* rowp = O + (size_t)(row0 + ai * HALF + m * 16) * ldc + col0;
#pragma unroll
                for (int bj = 0; bj < 2; ++bj) { const f32x4 v0 = acc[ai][bj][m][0], v1 = acc[ai][bj][m][1];
                    u32x4 w; w.x = cvt_pk_bf16(v0[0], v0[1]); w.y = cvt_pk_bf16(v0[2], v0[3]); w.z = cvt_pk_bf16(v1[0], v1[1]); w.w = cvt_pk_bf16(v1[2], v1[3]);
                    *(u32x4*)(rowp + bj * HALF) = w; }
            }
    }
};

template <class Epi>
__device__ __forceinline__ void gemm_phase(LAS unsigned char* lds, const Gemm g, const StaticOrder& S, const Epi& E) {
    const int tid = threadIdx.x, wid = __builtin_amdgcn_readfirstlane(tid >> 6), lane = tid & 63, wr = wid >> 2, wc = wid & 3, fr = lane & 15, fq = lane >> 4;
    const int K = g.K, nt = K / BK;
    unsigned voffA[2], voffB[2];
#pragma unroll
    for (int i = 0; i < 2; ++i) { int R, C; stage_rc(tid * 16 + i * 8192, R, C); const int Rb = Epi::PERM ? ((R & ~31) + perm32(R & 31)) : R;
        voffA[i] = (unsigned)(R * K + C) * 2u; voffB[i] = (unsigned)(Rb * K + C) * 2u; }
    const size_t kstep = (size_t)(BK * 2);
    const size_t hstep = (size_t)HALF * K * 2;
    const size_t tstep = 2 * hstep;
    const unsigned ldsw = (unsigned)wid * 1024u;
    const int aoff = lds_byte(wr * 64 + fr, fq * 8), boff = lds_byte(wc * 32 + fr, fq * 8);
#define PG8_SA(b, h) (((b) * 2 + (h)) * HTB)
#define PG8_SB(b, h) ((4 + (b) * 2 + (h)) * HTB)
#define PG8_STAGE(bufoff, gbase, voff) do { _Pragma("unroll") for (int _i = 0; _i < 2; ++_i) \
        __builtin_amdgcn_global_load_lds((const unsigned*)((const char*)(gbase) + (voff)[_i]), (LAS unsigned*)(lds + (bufoff) + ldsw + _i * 8192), 16, 0, 0); } while (0)
#define PG8_LDA(dst, b, h) do { _Pragma("unroll") for (int m = 0; m < 4; ++m) _Pragma("unroll") for (int k = 0; k < 2; ++k) dst[m][k] = *(const LAS bf16x8*)(lds + PG8_SA(b, h) + aoff + m * 2048 + k * 1024); } while (0)
#define PG8_LDB(dst, b, h) do { _Pragma("unroll") for (int n = 0; n < 2; ++n) _Pragma("unroll") for (int k = 0; k < 2; ++k) dst[n][k] = *(const LAS bf16x8*)(lds + PG8_SB(b, h) + boff + n * 2048 + k * 1024); } while (0)
#define PG8_MMA(ai, bj, At, Bt) do { __builtin_amdgcn_s_setprio(1); _Pragma("unroll") for (int m = 0; m < 4; ++m) _Pragma("unroll") for (int n = 0; n < 2; ++n) _Pragma("unroll") for (int k = 0; k < 2; ++k) \
        acc[ai][bj][m][n] = __builtin_amdgcn_mfma_f32_16x16x32_bf16(Bt[n][k], At[m][k], acc[ai][bj][m][n], 0, 0, 0); __builtin_amdgcn_s_setprio(0); } while (0)
#define PG8_WAIT_V(n) asm volatile("s_waitcnt vmcnt(" #n ")" ::: "memory")
#define PG8_WAIT_L(n) asm volatile("s_waitcnt lgkmcnt(" #n ")" ::: "memory")
#define PG8_BAR __builtin_amdgcn_s_barrier()
#define PG8_SCHED __builtin_amdgcn_sched_barrier(0)
    Unit cur, nxt; int ui = 0;
    if (!S.next(0, cur)) return;
    f32x4 acc[2][2][4][2];
#pragma unroll
    for (int a = 0; a < 2; ++a)
#pragma unroll
        for (int b = 0; b < 2; ++b)
#pragma unroll
            for (int m = 0; m < 4; ++m)
#pragma unroll
                for (int n = 0; n < 2; ++n) acc[a][b][m][n] = (f32x4){0.f, 0.f, 0.f, 0.f};
    bf16x8 At[4][2], B0[2][2], B1[2][2];
    const char* cA = (const char*)g.A + (size_t)cur.pm * tstep; const char* cB = (const char*)g.Bt + (size_t)cur.pn * tstep;
    PG8_STAGE(PG8_SB(0, 0), cB, voffB); PG8_STAGE(PG8_SA(0, 0), cA, voffA); PG8_STAGE(PG8_SB(0, 1), cB + hstep, voffB); PG8_STAGE(PG8_SA(0, 1), cA + hstep, voffA);
    if (wr == 1) PG8_BAR;
    PG8_WAIT_V(4); PG8_BAR;
    PG8_STAGE(PG8_SB(1, 0), cB + kstep, voffB); PG8_STAGE(PG8_SA(1, 0), cA + kstep, voffA); PG8_STAGE(PG8_SB(1, 1), cB + hstep + kstep, voffB);
    PG8_WAIT_V(6); PG8_BAR;
    for (;;) {
        const bool has_next = S.next(ui + 1, nxt);
        const char* nA = has_next ? (const char*)g.A + (size_t)nxt.pm * tstep : cA; const char* nB = has_next ? (const char*)g.Bt + (size_t)nxt.pn * tstep : cB;
        for (int t = 0; t < nt; t += 2) {
            const bool last = (t == nt - 2);
            const char* a1 = cA + (size_t)(t + 1) * kstep;
            const char* a2 = last ? nA : cA + (size_t)(t + 2) * kstep; const char* b2 = last ? nB : cB + (size_t)(t + 2) * kstep;
            const char* a3 = a2 + kstep; const char* b3 = b2 + kstep;
            PG8_LDB(B0, 0, 0); PG8_SCHED; PG8_LDA(At, 0, 0); PG8_STAGE(PG8_SA(1, 1), a1 + hstep, voffA);
            PG8_WAIT_L(8); PG8_BAR; PG8_WAIT_L(0); PG8_MMA(0, 0, At, B0); PG8_BAR; PG8_SCHED;
            PG8_LDB(B1, 0, 1); PG8_STAGE(PG8_SB(0, 0), b2, voffB);
            PG8_BAR; PG8_WAIT_L(0); PG8_MMA(0, 1, At, B1); PG8_BAR;
            PG8_LDA(At, 0, 1); PG8_STAGE(PG8_SA(0, 0), a2, voffA);
            PG8_BAR; PG8_WAIT_L(0); PG8_MMA(1, 0, At, B0); PG8_BAR; PG8_SCHED;
            PG8_STAGE(PG8_SB(0, 1), b2 + hstep, voffB);
            PG8_WAIT_V(6); PG8_BAR; PG8_MMA(1, 1, At, B1); PG8_BAR;
            PG8_LDB(B0, 1, 0); PG8_SCHED; PG8_LDA(At, 1, 0); PG8_STAGE(PG8_SA(0, 1), a2 + hstep, voffA);
            PG8_WAIT_L(8); PG8_BAR; PG8_WAIT_L(0); PG8_MMA(0, 0, At, B0); PG8_BAR; PG8_SCHED;
            PG8_LDB(B1, 1, 1); PG8_STAGE(PG8_SB(1, 0), b3, voffB);
            PG8_BAR; PG8_WAIT_L(0); PG8_MMA(0, 1, At, B1); PG8_BAR;
            PG8_LDA(At, 1, 1); PG8_STAGE(PG8_SA(1, 0), a3, voffA);
            PG8_BAR; PG8_WAIT_L(0); PG8_MMA(1, 0, At, B0); PG8_BAR; PG8_SCHED;
            PG8_STAGE(PG8_SB(1, 1), b3 + hstep, voffB);
            PG8_WAIT_V(6); PG8_BAR; PG8_MMA(1, 1, At, B1); PG8_BAR;
        }
        E(acc, cur, wr, wc, fr, fq);
        if (!has_next) break;
#pragma unroll
        for (int a = 0; a < 2; ++a)
#pragma unroll
            for (int b = 0; b < 2; ++b)
#pragma unroll
                for (int m = 0; m < 4; ++m)
#pragma unroll
                    for (int n = 0; n < 2; ++n) acc[a][b][m][n] = (f32x4){0.f, 0.f, 0.f, 0.f};
        cur = nxt; cA = nA; cB = nB; ++ui;
    }
    PG8_WAIT_V(0);
    if (wr == 0) PG8_BAR;
    PG8_BAR;
#undef PG8_SA
#undef PG8_SB
#undef PG8_STAGE
#undef PG8_LDA
#undef PG8_LDB
#undef PG8_MMA
#undef PG8_WAIT_V
#undef PG8_WAIT_L
#undef PG8_BAR
#undef PG8_SCHED
}
}

__device__ __forceinline__ void gemv_item(const Params& P, LAS unsigned char* lds, int item) {
    const int cgp = item % 72, ks = item / 72;
    const int tid = threadIdx.x, lane = tid & 63, wid = tid >> 6;
    LAS float* sc = (LAS float*)lds;
    LAS float* red = (LAS float*)(lds + 4096);
    for (int i = tid; i < 1024; i += 512) { const int b = i >> 8, kk = i & 255; const float v = P.c[b * DM + ks * 256 + kk]; sc[i] = v / (1.f + __expf(-v)); }
    LDS_BARRIER();
    float acc[4][4];
#pragma unroll
    for (int b = 0; b < 4; ++b)
#pragma unroll
        for (int e = 0; e < 4; ++e) acc[b][e] = 0.f;
    const float* wp = P.w_ada + (size_t)(ks * 256 + wid * 32) * NMOD + cgp * 256 + lane * 4;
#pragma unroll 8
    for (int r = 0; r < 32; ++r) {
        const f32x4 w = __builtin_nontemporal_load((const f32x4*)(wp + (size_t)r * NMOD));
        const int kk = wid * 32 + r;
#pragma unroll
        for (int b = 0; b < 4; ++b) { const float s = sc[b * 256 + kk];
#pragma unroll
            for (int e = 0; e < 4; ++e) acc[b][e] += s * w[e]; }
    }
#pragma unroll
    for (int b = 0; b < 4; ++b)
#pragma unroll
        for (int e = 0; e < 4; ++e) red[(wid * 16 + b * 4 + e) * 64 + lane] = acc[b][e];
    LDS_BARRIER();
    float* modp = (float*)(P.ws + WS_MODP);
    for (int o = tid; o < 1024; o += 512) { const int be = o >> 6, ln = o & 63; float s = 0.f;
#pragma unroll
        for (int w = 0; w < 8; ++w) s += red[(w * 16 + be) * 64 + ln];
        const int b = be >> 2, e = be & 3; modp[((size_t)ks * NB + b) * NMOD + cgp * 256 + ln * 4 + e] = s; }
    LDS_BARRIER();
}
__device__ __forceinline__ void wconv_tile(const float* W, int N, int k0, int n0, bf16_t* Bt, int Kd, int mode, LAS unsigned char* lds) {
    LAS float* tile = (LAS float*)lds;
    const int tid = threadIdx.x, col = tid & 255, rh = tid >> 8;
    float v[32];
    const bool ok = (n0 + col) < N;
    const float* src = W + (size_t)(k0 + rh) * N + n0 + col;
#pragma unroll
    for (int i = 0; i < 32; ++i) v[i] = ok ? __builtin_nontemporal_load(src + (size_t)(2 * i) * N) : 0.f;
#pragma unroll
    for (int i = 0; i < 32; ++i) tile[(2 * i + rh) * 257 + col] = v[i];
    LDS_BARRIER();
#pragma unroll
    for (int i = 0; i < 4; ++i) {
        const int o = tid + 512 * i, kg = o & 7, n = o >> 3;
        float f[8];
#pragma unroll
        for (int j = 0; j < 8; ++j) f[j] = tile[(8 * kg + j) * 257 + n];
        u32x4 w; w.x = cvt_pk_bf16(f[0], f[1]); w.y = cvt_pk_bf16(f[2], f[3]); w.z = cvt_pk_bf16(f[4], f[5]); w.w = cvt_pk_bf16(f[6], f[7]);
        const int nc = n0 + n;
        const int R = (mode == 0) ? nc : (256 * (nc >> 7) + (nc & 127) + (mode == 2 ? 128 : 0));
        *(u32x4*)(Bt + (size_t)R * Kd + k0 + 8 * kg) = w;
    }
    LDS_BARRIER();
}
constexpr int NT_FFN = 3 * 704, NT_WIN = 800, NT_WOUT = 256;
__device__ __forceinline__ void wconv_ffn_item(const Params& P, LAS unsigned char* lds, int i, const float* wg, const float* wu, const float* wd) {
    bf16_t* WUP = (bf16_t*)(P.ws + WS_WUP); bf16_t* WDN = (bf16_t*)(P.ws + WS_WDN);
    if (i < 704) wconv_tile(wg, DFF, (i / 22) * 64, (i % 22) * 256, WUP, DM, 1, lds);
    else if (i < 1408) { i -= 704; wconv_tile(wu, DFF, (i / 22) * 64, (i % 22) * 256, WUP, DM, 2, lds); }
    else { i -= 1408; wconv_tile(wd, DM, (i / 8) * 64, (i % 8) * 256, WDN, DFF, 0, lds); }
}
__device__ __forceinline__ void phase0(const Params& P, LAS unsigned char* lds) {
    constexpr int N_GEMV = 72 * KS_ADA;
    constexpr int NITEMS = N_GEMV + NT_FFN + NT_WIN + NT_WOUT;
    for (int it = blockIdx.x; it < NITEMS; it += gridDim.x) {
        int i = it;
        if (i < N_GEMV) { gemv_item(P, lds, i); continue; } i -= N_GEMV;
        if (i < NT_FFN) { wconv_ffn_item(P, lds, i, P.ffn1_wg, P.ffn1_wu, P.ffn1_wd); continue; } i -= NT_FFN;
        if (i < NT_WIN) { wconv_tile(P.w_in, NIN_REAL, (i / 25) * 64, (i % 25) * 256, (bf16_t*)(P.ws + WS_WIN), DM, 0, lds); continue; } i -= NT_WIN;
        wconv_tile(P.w_out, DM, (i / 8) * 64, (i % 8) * 256, (bf16_t*)(P.ws + WS_WOUT), DM, 0, lds);
    }
}

template <bool IN_BF16> __device__ __forceinline__ void norm_mod_phase(const Params& P, LAS unsigned char* lds, const void* xin_, const float* normw, int idx, bool from_partials, bf16_t* hout) {
    LAS float* As = (LAS float*)lds; LAS float* Bs = As + DM;
    const int tid = threadIdx.x, lane = tid & 63, wid = tid >> 6;
    const float* modp = (const float*)(P.ws + WS_MODP); const float* mods = (const float*)(P.ws + WS_MODS);
    for (int rb = blockIdx.x; rb < T_TOK / 64; rb += gridDim.x) {
        const int b = rb >> 6;
        __syncthreads();
        for (int k = tid; k < DM; k += 512) {
            float sh, sc;
            if (from_partials) {
                sh = P.b_ada[idx * DM + k]; sc = P.b_ada[(idx + 1) * DM + k];
#pragma unroll
                for (int s = 0; s < KS_ADA; ++s) { sh += modp[((size_t)s * NB + b) * NMOD + idx * DM + k]; sc += modp[((size_t)s * NB + b) * NMOD + (idx + 1) * DM + k]; }
            } else { sh = mods[(size_t)b * NMOD + idx * DM + k]; sc = mods[(size_t)b * NMOD + (idx + 1) * DM + k]; }
            As[k] = normw[k] * (1.f + sc); Bs[k] = sh;
        }
        __syncthreads();
        for (int rr = wid; rr < 64; rr += 16) {
            const int row0 = rb * 64 + rr, row1 = row0 + 8;
            f32x4 v0[8], v1[8]; float ss0 = 0.f, ss1 = 0.f;
            if (IN_BF16) {
                const u32x2* xr0 = (const u32x2*)((const bf16_t*)xin_ + (size_t)row0 * DM) + lane; const u32x2* xr1 = (const u32x2*)((const bf16_t*)xin_ + (size_t)row1 * DM) + lane;
                u32x2 r0[8], r1[8];
#pragma unroll
                for (int i = 0; i < 8; ++i) { r0[i] = xr0[64 * i]; r1[i] = xr1[64 * i]; }
#pragma unroll
                for (int i = 0; i < 8; ++i) { v0[i] = (f32x4){bf_lo(r0[i].x), bf_hi(r0[i].x), bf_lo(r0[i].y), bf_hi(r0[i].y)}; v1[i] = (f32x4){bf_lo(r1[i].x), bf_hi(r1[i].x), bf_lo(r1[i].y), bf_hi(r1[i].y)}; }
            } else {
                const f32x4* xr0 = (const f32x4*)((const float*)xin_ + (size_t)row0 * DM) + lane; const f32x4* xr1 = (const f32x4*)((const float*)xin_ + (size_t)row1 * DM) + lane;
#pragma unroll
                for (int i = 0; i < 8; ++i) { v0[i] = xr0[64 * i]; v1[i] = xr1[64 * i]; }
            }
#pragma unroll
            for (int i = 0; i < 8; ++i) { ss0 += (v0[i].x * v0[i].x + v0[i].y * v0[i].y) + (v0[i].z * v0[i].z + v0[i].w * v0[i].w);
                                          ss1 += (v1[i].x * v1[i].x + v1[i].y * v1[i].y) + (v1[i].z * v1[i].z + v1[i].w * v1[i].w); }
#pragma unroll
            for (int o = 1; o < 64; o <<= 1) { const float t0 = __shfl_xor(ss0, o), t1 = __shfl_xor(ss1, o); ss0 += t0; ss1 += t1; }
            const float rstd0 = 1.f / sqrtf(ss0 * (1.f / DM) + 1e-6f), rstd1 = 1.f / sqrtf(ss1 * (1.f / DM) + 1e-6f);
            u32x2* o80 = (u32x2*)(hout + (size_t)row0 * DM) + lane; u32x2* o81 = (u32x2*)(hout + (size_t)row1 * DM) + lane;
#pragma unroll
            for (int i = 0; i < 8; ++i) { const int k = (lane + 64 * i) * 4;
                const f32x4 a = *(const LAS f32x4*)(As + k), bb = *(const LAS f32x4*)(Bs + k);
                const f32x4 p0 = v0[i] * rstd0 * a + bb, p1 = v1[i] * rstd1 * a + bb;
                u32x2 w; w.x = cvt_pk_bf16(p0.x, p0.y); w.y = cvt_pk_bf16(p0.z, p0.w); o80[64 * i] = w;
                w.x = cvt_pk_bf16(p1.x, p1.y); w.y = cvt_pk_bf16(p1.z, p1.w); o81[64 * i] = w; }
        }
    }
}
__device__ __forceinline__ void mods_finalize(const Params& P) {
    const float* modp = (const float*)(P.ws + WS_MODP); float* mods = (float*)(P.ws + WS_MODS);
    for (int i = blockIdx.x * 512 + threadIdx.x; i < NB * NMOD; i += gridDim.x * 512) {
        const int b = i / NMOD, col = i % NMOD; float s = P.b_ada[col];
#pragma unroll
        for (int ks = 0; ks < KS_ADA; ++ks) s += modp[((size_t)ks * NB + b) * NMOD + col];
        mods[i] = s;
    }
}

__device__ __forceinline__ void gate_cols_phase(const Params& P, LAS unsigned char* lds) {
    const bf16_t* Hh = (const bf16_t*)(P.ws + WS_H); const bf16_t* WINp = (const bf16_t*)(P.ws + WS_WIN); bf16_t* PB = (bf16_t*)(P.ws + WS_BIG);
    const int tid = threadIdx.x, lane = tid & 63, wid = tid >> 6, fr = lane & 15, fq = lane >> 4, mt = wid & 3, kh = wid >> 2;
    LAS f32x4* part = (LAS f32x4*)lds;
    for (int rb = blockIdx.x; rb < T_TOK / 64; rb += gridDim.x) {
        const bf16_t* ap = Hh + (size_t)(rb * 64 + 16 * mt + fr) * DM + kh * 1024 + 8 * fq;
        const bf16_t* bp = WINp + (size_t)(6144 + fr) * DM + kh * 1024 + 8 * fq;
        f32x4 acc = (f32x4){0.f, 0.f, 0.f, 0.f};
#pragma unroll 1
        for (int k0 = 0; k0 < 32; k0 += 8) {
            bf16x8 a[8], b[8];
#pragma unroll
            for (int i = 0; i < 8; ++i) { a[i] = *(const bf16x8*)(ap + (k0 + i) * 32); b[i] = *(const bf16x8*)(bp + (k0 + i) * 32); }
#pragma unroll
            for (int i = 0; i < 8; ++i) acc = __builtin_amdgcn_mfma_f32_16x16x32_bf16(a[i], b[i], acc, 0, 0, 0);
        }
        LDS_BARRIER();
        if (kh == 1) part[mt * 64 + lane] = acc;
        LDS_BARRIER();
        if (kh == 0) {
            acc += part[mt * 64 + lane];
            bf16_t* op = PB + (size_t)(rb * 64 + 16 * mt + 4 * fq) * NIN + 6144 + fr;
#pragma unroll
            for (int j = 0; j < 4; ++j) op[(size_t)j * NIN] = (bf16_t)(cvt_pk_bf16(acc[j], 0.f) & 0xffffu);
        }
    }
}

__device__ __forceinline__ void conv_item(const Params& P, LAS unsigned char* lds, int item) {
    const bf16_t* PB = (const bf16_t*)(P.ws + WS_BIG); bf16_t* Y = (bf16_t*)(P.ws + WS_H);
    const int tid = threadIdx.x;
    const int b = item >> 7, t0 = (item & 127) * 32, ch = tid * 2;
    LAS unsigned* hs = (LAS unsigned*)lds + tid;
    LAS float* ps = (LAS float*)lds;
    LAS float* stat = (LAS float*)(lds + 131072);
    const bf16_t* colp = PB + (size_t)b * SEQ * NIN + ch;
#pragma unroll 1
    for (int j0 = 0; j0 < 64; j0 += 16) {
        unsigned ra[16], rg[16];
#pragma unroll
        for (int jj = 0; jj < 16; ++jj) { const int j = j0 + jj, tt = t0 - 30 + j, tc = tt < 0 ? 0 : (j < 62 ? tt : t0);
            const bf16_t* rp = colp + (size_t)tc * NIN; ra[jj] = *(const unsigned*)rp; rg[jj] = *(const unsigned*)(rp + 1024); }
#pragma unroll
        for (int jj = 0; jj < 16; ++jj) { const int j = j0 + jj, tt = t0 - 30 + j;
            float h0 = bf_lo(ra[jj]) * fast_sigmoid(bf_lo(rg[jj])), h1 = bf_hi(ra[jj]) * fast_sigmoid(bf_hi(rg[jj]));
            const bool ok = (tt >= 0) && (j < 62);
            h0 = ok ? h0 : 0.f; h1 = ok ? h1 : 0.f;
            if (j < 63) hs[j * 512] = cvt_pk_bf16(h0, h1); }
    }
    float acc0[32], acc1[32];
#pragma unroll
    for (int i = 0; i < 32; ++i) { acc0[i] = 0.f; acc1[i] = 0.f; }
#pragma unroll 1
    for (int g = 0; g < 8; ++g) {
        f32x2 w[4];
#pragma unroll
        for (int t = 0; t < 4; ++t) { const int tap = 4 * g + t; w[t] = *(const f32x2*)(P.w_dw + (tap < 31 ? tap : 30) * 1024 + ch); if (tap >= 31) w[t] = (f32x2){0.f, 0.f}; }
        const LAS unsigned* hp = hs + g * 4 * 512;
        float hl[35], hh[35];
#pragma unroll
        for (int r = 0; r < 35; ++r) { const unsigned hv = hp[r * 512]; hl[r] = bf_lo(hv); hh[r] = bf_hi(hv); }
#pragma unroll
        for (int i = 0; i < 32; ++i)
#pragma unroll
            for (int t = 0; t < 4; ++t) { acc0[i] += w[t].x * hl[i + t]; acc1[i] += w[t].y * hh[i + t]; }
    }
    const f32x2 bd = *(const f32x2*)(P.b_dw + ch);
    LDS_BARRIER();
#pragma unroll
    for (int i = 0; i < 32; ++i) {
        acc0[i] += bd.x; acc1[i] += bd.y;
        ps[i * 512 + tid] = acc0[i] + acc1[i];
        ps[16384 + i * 512 + tid] = acc0[i] * acc0[i] + acc1[i] * acc1[i];
    }
    LDS_BARRIER();
    {
        const int tok = tid >> 4, part = tid & 15;
        float s = 0.f, q = 0.f;
#pragma unroll
        for (int k = 0; k < 8; ++k) { const int off = tok * 512 + part * 32 + ((k + part) & 7) * 4;
            const f32x4 a = *(const LAS f32x4*)(ps + off), c = *(const LAS f32x4*)(ps + 16384 + off);
            s += (a[0] + a[1]) + (a[2] + a[3]); q += (c[0] + c[1]) + (c[2] + c[3]); }
#pragma unroll
        for (int o = 1; o < 16; o <<= 1) { s += __shfl_xor(s, o); q += __shfl_xor(q, o); }
        if (part == 0) { const float mu = s * (1.f / 1024.f), var = fmaxf(q * (1.f / 1024.f) - mu * mu, 0.f);
            stat[tok * 2] = mu; stat[tok * 2 + 1] = 1.f / sqrtf(var + 1e-6f); }
    }
    LDS_BARRIER();
    const f32x2 lw = *(const f32x2*)(P.conv_ln_w + ch), lb = *(const f32x2*)(P.conv_ln_b + ch);
    bf16_t* yp = Y + (size_t)(b * SEQ + t0) * DM + ch;
#pragma unroll
    for (int i = 0; i < 32; ++i) {
        const float mu = stat[i * 2], rstd = stat[i * 2 + 1];
        const float y0 = (acc0[i] - mu) * rstd * lw.x + lb.x, y1 = (acc1[i] - mu) * rstd * lw.y + lb.y;
        *(unsigned*)(yp + (size_t)i * DM) = cvt_pk_bf16(fast_silu(y0), fast_silu(y1));
    }
    LDS_BARRIER();
}

constexpr int PL_KH = 0, PL_QH = 17408, PL_RHS = 34816, PL_LM = 100352, PL_G = 117760, PL_BETA = 118016, PL_END = 118272;
constexpr int KH_STRIDE = 272;
constexpr int LM_STRIDE = 68;

__device__ __forceinline__ void dn_gate_load(const Params& P, int ch, float& gb, float& ga) {
    const bf16_t* PB = (const bf16_t*)(P.ws + WS_BIG);
    const int bh = ch >> 6, n = ch & 63, b = bh >> 3, h = bh & 7;
    const bf16_t* rp = PB + ((size_t)b * SEQ + n * 64 + (threadIdx.x & 63)) * NIN + 6144 + h;
    gb = bf1(rp[0]); ga = bf1(rp[8]);
}
__device__ __forceinline__ void dn_prep_chunk(const Params& P, LAS unsigned char* lds, int ch, float& gb, float& ga, int ch_next) {
    const bf16_t* PB = (const bf16_t*)(P.ws + WS_BIG);
    unsigned char* ops = P.ws + WS_SCAN + (size_t)ch * OPS_BYTES;
    const int tid = threadIdx.x, lane = tid & 63, wid = tid >> 6;
    const int bh = ch >> 6, n = ch & 63, b = bh >> 3, h = bh & 7;
    const size_t tok0 = (size_t)b * SEQ + n * 64;
    LAS float* Gs = (LAS float*)(lds + PL_G); LAS float* Bes = (LAS float*)(lds + PL_BETA);
    LAS float* RHS = (LAS float*)(lds + PL_RHS); LAS float* LM = (LAS float*)(lds + PL_LM);
    const int r0 = 4 * (tid >> 5), d4 = 4 * (tid & 31);
    u32x2 raw[3][7];
#pragma unroll
    for (int X = 0; X < 3; ++X)
#pragma unroll
        for (int j = 0; j < 7; ++j) {
            const int tl = n * 64 + r0 - 3 + j, tlc = tl < 0 ? 0 : tl;
            const u32x2 v = *(const u32x2*)(PB + ((size_t)b * SEQ + tlc) * NIN + 2048 + 1024 * X + h * 128 + d4);
            raw[X][j].x = tl >= 0 ? v.x : 0u; raw[X][j].y = tl >= 0 ? v.y : 0u;
        }
    if (wid == 0) {
        const float braw = gb, araw = ga;
        if (ch_next >= 0) dn_gate_load(P, ch_next, gb, ga);
        const float beta = 1.f / (1.f + __expf(-braw));
        const float xx = araw + P.dt_bias[h];
        const float sp = (xx > 20.f) ? xx : log1pf(__expf(xx));
        float g = -__expf(P.a_log[h]) * sp;
#pragma unroll
        for (int o = 1; o < 64; o <<= 1) { const float t = __shfl_up(g, o); if (lane >= o) g += t; }
        Gs[lane] = g; Bes[lane] = beta;
        if (lane == 63) ((float*)(P.ws + WS_GL))[ch] = __expf(g);
    }
    LDS_BARRIER();
    {
        const float Glast = Gs[63];
        float Gr[4], ber[4];
#pragma unroll
        for (int i = 0; i < 4; ++i) { Gr[i] = Gs[r0 + i]; ber[i] = Bes[r0 + i]; }
        float val[3][4][4];
#pragma unroll
        for (int X = 0; X < 3; ++X) {
            const int chX = 1024 * X + h * 128 + d4;
            f32x4 wt[4];
#pragma unroll
            for (int j = 0; j < 4; ++j) wt[j] = *(const f32x4*)(P.w_short + j * 3072 + chX);
            f32x4 xin[7];
#pragma unroll
            for (int j = 0; j < 7; ++j) xin[j] = (f32x4){bf_lo(raw[X][j].x), bf_hi(raw[X][j].x), bf_lo(raw[X][j].y), bf_hi(raw[X][j].y)};
#pragma unroll
            for (int i = 0; i < 4; ++i) {
                f32x4 s = wt[0] * xin[i] + wt[1] * xin[i + 1] + wt[2] * xin[i + 2] + wt[3] * xin[i + 3];
#pragma unroll
                for (int e = 0; e < 4; ++e) val[X][i][e] = fast_silu(s[e]);
            }
        }
        {
            float ss[8];
#pragma unroll
            for (int v = 0; v < 8; ++v) { const int X = v >> 2, i = v & 3;
                ss[v] = (val[X][i][0] * val[X][i][0] + val[X][i][1] * val[X][i][1]) + (val[X][i][2] * val[X][i][2] + val[X][i][3] * val[X][i][3]); }
#pragma unroll
            for (int o = 1; o < 32; o <<= 1) {
                float t[8];
#pragma unroll
                for (int v = 0; v < 8; ++v) t[v] = __shfl_xor(ss[v], o);
#pragma unroll
                for (int v = 0; v < 8; ++v) ss[v] += t[v];
            }
#pragma unroll
            for (int v = 0; v < 8; ++v) { const int X = v >> 2, i = v & 3;
                const float sc = __builtin_amdgcn_rsqf(ss[v] + 1e-6f) * (X == 0 ? 0.08838834764831845f : 1.f);
#pragma unroll
                for (int e = 0; e < 4; ++e) val[X][i][e] *= sc; }
        }
        const int kb = d4 >> 5, hi = (d4 >> 4) & 1, fqd = (d4 >> 2) & 3;
#pragma unroll
        for (int i = 0; i < 4; ++i) {
            const int r = r0 + i;
            u32x2 w;
            w.x = cvt_pk_bf16(val[1][i][0], val[1][i][1]); w.y = cvt_pk_bf16(val[1][i][2], val[1][i][3]);
            *(LAS u32x2*)(lds + PL_KH + r * KH_STRIDE + d4 * 2) = w;
            w.x = cvt_pk_bf16(val[0][i][0], val[0][i][1]); w.y = cvt_pk_bf16(val[0][i][2], val[0][i][3]);
            *(LAS u32x2*)(lds + PL_QH + r * KH_STRIDE + d4 * 2) = w;
            const float be = ber[i], beg = be * __expf(Gr[i]);
            *(LAS f32x4*)(RHS + r * 256 + d4) = (f32x4){val[2][i][0] * be, val[2][i][1] * be, val[2][i][2] * be, val[2][i][3] * be};
            *(LAS f32x4*)(RHS + r * 256 + 128 + d4) = (f32x4){val[1][i][0] * beg, val[1][i][1] * beg, val[1][i][2] * beg, val[1][i][3] * beg};
            const float eg = __expf(Gr[i]);
            w.x = cvt_pk_bf16(val[0][i][0] * eg, val[0][i][1] * eg); w.y = cvt_pk_bf16(val[0][i][2] * eg, val[0][i][3] * eg);
            const int mt = r >> 4, fr = r & 15;
            *(u32x2*)(ops + OPS_Q + ((mt * 4 + kb) * 64 + fqd * 16 + fr) * 16 + hi * 8) = w;
        }
        float ek[4];
#pragma unroll
        for (int i = 0; i < 4; ++i) ek[i] = __expf(Glast - Gr[i]);
        const int kb2 = r0 >> 5, hi2 = (r0 >> 4) & 1, fq2 = (r0 >> 2) & 3;
#pragma unroll
        for (int e = 0; e < 4; ++e) {
            const int d = d4 + e, dt = d >> 4, fr2 = d & 15;
            u32x2 w; w.x = cvt_pk_bf16(val[1][0][e] * ek[0], val[1][1][e] * ek[1]); w.y = cvt_pk_bf16(val[1][2][e] * ek[2], val[1][3][e] * ek[3]);
            *(u32x2*)(ops + OPS_KT + ((dt * 2 + kb2) * 64 + fq2 * 16 + fr2) * 16 + hi2 * 8) = w;
        }
    }
    LDS_BARRIER();
    {
        const int fr = lane & 15, fq = lane >> 4;
        for (int job = wid; job < 26; job += 8) {
            int ct, st; bool isL;
            if (job < 10) { isL = true; int j = job; ct = 0; while (j > ct) { j -= ct + 1; ++ct; } st = j; }
            else { isL = false; const int j = job - 10; ct = j >> 2; st = j & 3; }
            if (isL) {
                f32x4 acc = (f32x4){0.f, 0.f, 0.f, 0.f};
                bf16x8 fa[4], fbb[4];
#pragma unroll
                for (int kb = 0; kb < 4; ++kb) { fa[kb] = *(const LAS bf16x8*)(lds + PL_KH + (16 * ct + fr) * KH_STRIDE + kb * 64 + fq * 16);
                    fbb[kb] = *(const LAS bf16x8*)(lds + PL_KH + (16 * st + fr) * KH_STRIDE + kb * 64 + fq * 16); }
                __builtin_amdgcn_sched_barrier(0);
#pragma unroll
                for (int kb = 0; kb < 4; ++kb) acc = __builtin_amdgcn_mfma_f32_16x16x32_bf16(fa[kb], fbb[kb], acc, 0, 0, 0);
                const int s = 16 * st + fr; const float Gsv = Gs[s];
#pragma unroll
                for (int j = 0; j < 4; ++j) { const int c = 16 * ct + 4 * fq + j;
                    const float v = (c > s) ? Bes[c] * acc[j] * __expf(Gs[c] - Gsv) : 0.f;
                    LM[c * LM_STRIDE + s] = v; }
            } else {
                u32x2 w; w.x = 0u; w.y = 0u;
                if (ct >= st) {
                    f32x4 acc = (f32x4){0.f, 0.f, 0.f, 0.f};
                    bf16x8 fa[4], fbb[4];
#pragma unroll
                    for (int kb = 0; kb < 4; ++kb) { fa[kb] = *(const LAS bf16x8*)(lds + PL_KH + (16 * st + fr) * KH_STRIDE + kb * 64 + fq * 16);
                        fbb[kb] = *(const LAS bf16x8*)(lds + PL_QH + (16 * ct + fr) * KH_STRIDE + kb * 64 + fq * 16); }
                    __builtin_amdgcn_sched_barrier(0);
#pragma unroll
                    for (int kb = 0; kb < 4; ++kb) acc = __builtin_amdgcn_mfma_f32_16x16x32_bf16(fa[kb], fbb[kb], acc, 0, 0, 0);
                    const int c = 16 * ct + fr; const float Gc = Gs[c];
                    float v[4];
#pragma unroll
                    for (int j = 0; j < 4; ++j) { const int s = 16 * st + 4 * fq + j; v[j] = (c >= s) ? acc[j] * __expf(Gc - Gs[s]) : 0.f; }
                    w.x = cvt_pk_bf16(v[0], v[1]); w.y = cvt_pk_bf16(v[2], v[3]);
                }
                *(u32x2*)(ops + OPS_A + ((ct * 2 + (st >> 1)) * 64 + fq * 16 + fr) * 16 + (st & 1) * 8) = w;
            }
        }
    }
    LDS_BARRIER();
    if (tid < 256) {
        LAS float* lmb = LM; asm volatile("" : "+v"(lmb));
        LAS float* rhb = RHS + tid;
        float sol[64];
        f32x4 lb[2][16];
        float rv[2];
        rv[0] = rhb[0];
#pragma unroll
        for (int c = 0; c < 64; ++c) {
            if (c + 1 < 64) {
                rv[(c + 1) & 1] = rhb[(c + 1) * 256];
#pragma unroll
                for (int s4 = 0; s4 < (c + 4) / 4; ++s4) lb[(c + 1) & 1][s4] = *(const LAS f32x4*)(lmb + (c + 1) * LM_STRIDE + 4 * s4);
            }
            float xq[4] = {rv[c & 1], 0.f, 0.f, 0.f};
#pragma unroll
            for (int s4 = 0; s4 < (c + 3) / 4; ++s4) {
                const f32x4 l = lb[c & 1][s4];
#pragma unroll
                for (int e = 0; e < 4; ++e) if (4 * s4 + e < c) xq[e] -= l[e] * sol[4 * s4 + e];
            }
            sol[c] = (xq[0] + xq[1]) + (xq[2] + xq[3]);
        }
#pragma unroll
        for (int c = 0; c < 64; ++c) rhb[c * 256] = sol[c];
    }
    LDS_BARRIER();
#pragma unroll
    for (int i = 0; i < 2; ++i) {
        const int item = tid + 512 * i, f = item >> 6, ln = item & 63, fr = ln & 15, fq = ln >> 4, mt = f >> 2, kb = f & 3;
        const int c = 16 * mt + fr, dk = 32 * kb + 4 * fq;
        const f32x4 a = *(const LAS f32x4*)(RHS + c * 256 + 128 + dk), bb = *(const LAS f32x4*)(RHS + c * 256 + 128 + dk + 16);
        u32x4 w; w.x = cvt_pk_bf16(-a.x, -a.y); w.y = cvt_pk_bf16(-a.z, -a.w); w.z = cvt_pk_bf16(-bb.x, -bb.y); w.w = cvt_pk_bf16(-bb.z, -bb.w);
        *(u32x4*)(ops + OPS_W + item * 16) = w;
    }
#pragma unroll
    for (int i = 0; i < 2; ++i) {
        const int item = tid + 512 * i, f = item >> 6, ln = item & 63, fr = ln & 15, fq = ln >> 4, ds = f >> 1, mp = f & 1;
        float v[8];
#pragma unroll
        for (int j = 0; j < 4; ++j) { v[j] = RHS[(32 * mp + 4 * fq + j) * 256 + 16 * ds + fr]; v[4 + j] = RHS[(32 * mp + 16 + 4 * fq + j) * 256 + 16 * ds + fr]; }
        u32x4 w; w.x = cvt_pk_bf16(v[0], v[1]); w.y = cvt_pk_bf16(v[2], v[3]); w.z = cvt_pk_bf16(v[4], v[5]); w.w = cvt_pk_bf16(v[6], v[7]);
        *(u32x4*)(ops + OPS_U + item * 16) = w;
    }
    LDS_BARRIER();
}

__device__ __forceinline__ void scan_issue(LAS unsigned char* buf, const unsigned char* ops, int lane) {
#pragma unroll
    for (int f = 0; f < 56; ++f)
        __builtin_amdgcn_global_load_lds((const unsigned*)(ops + f * 1024 + lane * 16), (LAS unsigned*)(buf + f * 1024), 16, 0, 0);
}
__device__ __forceinline__ bf16x8 pack8(const f32x4 a, const f32x4 b) {
    u32x4 w; w.x = cvt_pk_bf16(a[0], a[1]); w.y = cvt_pk_bf16(a[2], a[3]); w.z = cvt_pk_bf16(b[0], b[1]); w.w = cvt_pk_bf16(b[2], b[3]);
    return __builtin_bit_cast(bf16x8, w);
}
__device__ __forceinline__ void scan_chain(const Params& P, LAS unsigned char* lds, int chain) {
    const int lane = threadIdx.x & 63, fr = lane & 15, fq = lane >> 4;
    const int xcd = chain & 7, idx = chain >> 3, ds = idx & 7, bh = xcd + 8 * (idx >> 3), b = bh >> 3, h = bh & 7;
    const unsigned char* ops0 = P.ws + WS_SCAN + (size_t)(bh * 64) * OPS_BYTES;
    bf16_t* O = (bf16_t*)(P.ws + WS_O);
    LAS float* OT = (LAS float*)(lds + 2 * 57344);
    float glall = ((const float*)(P.ws + WS_GL))[bh * 64 + lane];
    f32x4 S[8]; bf16x8 Sb[4];
#pragma unroll
    for (int i = 0; i < 8; ++i) S[i] = (f32x4){0.f, 0.f, 0.f, 0.f};
#pragma unroll
    for (int i = 0; i < 4; ++i) Sb[i] = (bf16x8){0, 0, 0, 0, 0, 0, 0, 0};
    scan_issue(lds, ops0, lane);
    u32x4 Un[2];
    Un[0] = *(const u32x4*)(ops0 + OPS_U + ((ds * 2 + 0) * 64 + lane) * 16); Un[1] = *(const u32x4*)(ops0 + OPS_U + ((ds * 2 + 1) * 64 + lane) * 16);
    for (int n = 0; n < 64; ++n) {
        asm volatile("s_waitcnt vmcnt(0)" ::: "memory");
        __builtin_amdgcn_sched_barrier(0);
        asm volatile("" : "+v"(Un[0]), "+v"(Un[1]), "+v"(glall));
        const u32x4 U0 = Un[0], U1 = Un[1];
        const float egl = __builtin_bit_cast(float, __builtin_amdgcn_readlane(__builtin_bit_cast(int, glall), n));
        LAS unsigned char* buf = lds + (n & 1) * 57344;
        if (n + 1 < 64) {
            const unsigned char* opn = ops0 + (size_t)(n + 1) * OPS_BYTES;
            scan_issue(lds + ((n + 1) & 1) * 57344, opn, lane);
            Un[0] = *(const u32x4*)(opn + OPS_U + ((ds * 2 + 0) * 64 + lane) * 16); Un[1] = *(const u32x4*)(opn + OPS_U + ((ds * 2 + 1) * 64 + lane) * 16);
        }
        __builtin_amdgcn_sched_barrier(0);
#define SC_LD(dst, base, idx) dst = *(const LAS bf16x8*)(buf + (base) + ((idx) * 64 + lane) * 16)
#define SC_SB __builtin_amdgcn_sched_barrier(0)
        bf16x8 fa[8], fb[8];
        f32x4 vn[4], o[4];
        vn[0] = (f32x4){bf_lo(U0.x), bf_hi(U0.x), bf_lo(U0.y), bf_hi(U0.y)}; vn[1] = (f32x4){bf_lo(U0.z), bf_hi(U0.z), bf_lo(U0.w), bf_hi(U0.w)};
        vn[2] = (f32x4){bf_lo(U1.x), bf_hi(U1.x), bf_lo(U1.y), bf_hi(U1.y)}; vn[3] = (f32x4){bf_lo(U1.z), bf_hi(U1.z), bf_lo(U1.w), bf_hi(U1.w)};
#pragma unroll
        for (int mt = 0; mt < 4; ++mt) o[mt] = (f32x4){0.f, 0.f, 0.f, 0.f};
#pragma unroll
        for (int mt = 0; mt < 4; ++mt) { SC_LD(fa[mt * 2 + 0], OPS_W, mt * 4 + 0); SC_LD(fa[mt * 2 + 1], OPS_W, mt * 4 + 1); }
        SC_SB;
#pragma unroll
        for (int mt = 0; mt < 4; ++mt) { SC_LD(fb[mt * 2 + 0], OPS_W, mt * 4 + 2); SC_LD(fb[mt * 2 + 1], OPS_W, mt * 4 + 3); }
        SC_SB;
#pragma unroll
        for (int k = 0; k < 2; ++k)
#pragma unroll
            for (int mt = 0; mt < 4; ++mt) vn[mt] = __builtin_amdgcn_mfma_f32_16x16x32_bf16(fa[mt * 2 + k], Sb[k], vn[mt], 0, 0, 0);
        SC_SB;
#pragma unroll
        for (int mt = 0; mt < 4; ++mt) { SC_LD(fa[mt * 2 + 0], OPS_Q, mt * 4 + 0); SC_LD(fa[mt * 2 + 1], OPS_Q, mt * 4 + 1); }
        SC_SB;
#pragma unroll
        for (int k = 0; k < 2; ++k)
#pragma unroll
            for (int mt = 0; mt < 4; ++mt) vn[mt] = __builtin_amdgcn_mfma_f32_16x16x32_bf16(fb[mt * 2 + k], Sb[2 + k], vn[mt], 0, 0, 0);
        bf16x8 vb[2]; vb[0] = pack8(vn[0], vn[1]); vb[1] = pack8(vn[2], vn[3]);
        SC_SB;
#pragma unroll
        for (int mt = 0; mt < 4; ++mt) { SC_LD(fb[mt * 2 + 0], OPS_Q, mt * 4 + 2); SC_LD(fb[mt * 2 + 1], OPS_Q, mt * 4 + 3); }
        SC_SB;
#pragma unroll
        for (int k = 0; k < 2; ++k)
#pragma unroll
            for (int mt = 0; mt < 4; ++mt) o[mt] = __builtin_amdgcn_mfma_f32_16x16x32_bf16(fa[mt * 2 + k], Sb[k], o[mt], 0, 0, 0);
        SC_SB;
#pragma unroll
        for (int i = 0; i < 8; ++i) SC_LD(fa[i], OPS_A, i);
        SC_SB;
#pragma unroll
        for (int k = 0; k < 2; ++k)
#pragma unroll
            for (int mt = 0; mt < 4; ++mt) o[mt] = __builtin_amdgcn_mfma_f32_16x16x32_bf16(fb[mt * 2 + k], Sb[2 + k], o[mt], 0, 0, 0);
        SC_SB;
#pragma unroll
        for (int i = 0; i < 8; ++i) SC_LD(fb[i], OPS_KT, i);
        SC_SB;
#pragma unroll
        for (int k2 = 0; k2 < 2; ++k2)
#pragma unroll
            for (int mt = 0; mt < 4; ++mt) o[mt] = __builtin_amdgcn_mfma_f32_16x16x32_bf16(fa[mt * 2 + k2], vb[k2], o[mt], 0, 0, 0);
        SC_SB;
#pragma unroll
        for (int i = 0; i < 8; ++i) SC_LD(fa[i], OPS_KT, 8 + i);
        SC_SB;
        {
#pragma unroll
            for (int mt = 0; mt < 4; ++mt)
#pragma unroll
                for (int j = 0; j < 4; ++j) OT[(16 * mt + 4 * fq + j) * 20 + fr] = o[mt][j];
            bf16_t* op = O + ((size_t)b * SEQ + n * 64 + (lane >> 2)) * 1024 + h * 128 + ds * 16 + (lane & 3) * 4;
#pragma unroll
            for (int i = 0; i < 4; ++i) { const f32x4 v = *(const LAS f32x4*)(OT + (16 * i + (lane >> 2)) * 20 + (lane & 3) * 4);
                u32x2 w; w.x = cvt_pk_bf16(v[0], v[1]); w.y = cvt_pk_bf16(v[2], v[3]); *(u32x2*)(op + (size_t)(16 * i) * 1024) = w; }
        }
        SC_SB;
#pragma unroll
        for (int dt = 0; dt < 8; ++dt) S[dt] *= egl;
#pragma unroll
        for (int k2 = 0; k2 < 2; ++k2)
#pragma unroll
            for (int dt = 0; dt < 4; ++dt) S[dt] = __builtin_amdgcn_mfma_f32_16x16x32_bf16(fb[dt * 2 + k2], vb[k2], S[dt], 0, 0, 0);
        SC_SB;
#pragma unroll
        for (int k2 = 0; k2 < 2; ++k2)
#pragma unroll
            for (int dt = 0; dt < 4; ++dt) S[4 + dt] = __builtin_amdgcn_mfma_f32_16x16x32_bf16(fa[dt * 2 + k2], vb[k2], S[4 + dt], 0, 0, 0);
        SC_SB;
#undef SC_LD
#undef SC_SB
#pragma unroll
        for (int kb = 0; kb < 4; ++kb) Sb[kb] = pack8(S[2 * kb], S[2 * kb + 1]);
        __builtin_amdgcn_sched_barrier(0);
        asm volatile("s_waitcnt lgkmcnt(0)" ::: "memory");
    }
    asm volatile("s_waitcnt vmcnt(0)" ::: "memory");
}

struct WcItem { const float* src; bf16_t* dst; int N, Kd; };
constexpr int NWL_FFN = 3 * 5632;
constexpr int SC_CONV = 2 * 57344 + 5120;
constexpr int SC_CONV_WAVE = 8704;
__device__ __forceinline__ WcItem wc_item(const Params& P, int i, const float* wg, const float* wu, const float* wd) {
    bf16_t* WUP = (bf16_t*)(P.ws + WS_WUP); bf16_t* WDN = (bf16_t*)(P.ws + WS_WDN);
    WcItem it;
    if (i < 11264) { const int up = i >= 5632; if (up) i -= 5632; const int k0 = (i / 176) * 64, n0 = (i % 176) * 32;
        it.src = (up ? wu : wg) + (size_t)k0 * DFF + n0; it.N = DFF; it.Kd = DM; it.dst = WUP + (size_t)(256 * (n0 >> 7) + (n0 & 127) + (up ? 128 : 0)) * DM + k0; }
    else { i -= 11264; const int k0 = (i / 64) * 64, n0 = (i % 64) * 32; it.src = wd + (size_t)k0 * DM + n0; it.N = DM; it.Kd = DFF; it.dst = WDN + (size_t)n0 * DFF + k0; }
    return it;
}
__device__ __forceinline__ void wc_load(const WcItem& it, f32x4 (&v)[8], int lane) {
    const int r = lane >> 3, c4 = (lane & 7) * 4;
#pragma unroll
    for (int i = 0; i < 8; ++i) v[i] = __builtin_nontemporal_load((const f32x4*)(it.src + (size_t)(8 * i + r) * it.N + c4));
}
__device__ __forceinline__ void wc_store(const WcItem& it, const f32x4 (&v)[8], LAS float* scr, int lane) {
    const int r = lane >> 3, c4 = (lane & 7) * 4;
#pragma unroll
    for (int i = 0; i < 8; ++i) { LAS float* d = scr + (8 * i + r) * 34 + c4; *(LAS f32x2*)d = (f32x2){v[i][0], v[i][1]}; *(LAS f32x2*)(d + 2) = (f32x2){v[i][2], v[i][3]}; }
    asm volatile("s_waitcnt lgkmcnt(0)" ::: "memory");
#pragma unroll
    for (int j = 0; j < 4; ++j) {
        const int o = lane + 64 * j, kg = o & 7, n = o >> 3;
        float f[8];
#pragma unroll
        for (int t = 0; t < 8; ++t) f[t] = scr[(8 * kg + t) * 34 + n];
        u32x4 w; w.x = cvt_pk_bf16(f[0], f[1]); w.y = cvt_pk_bf16(f[2], f[3]); w.z = cvt_pk_bf16(f[4], f[5]); w.w = cvt_pk_bf16(f[6], f[7]);
        *(u32x4*)(it.dst + (size_t)n * it.Kd + 8 * kg) = w;
    }
    asm volatile("s_waitcnt lgkmcnt(0)" ::: "memory");
}
__device__ __forceinline__ void wc_wave_loop(const Params& P, const float* wg, const float* wu, const float* wd, LAS float* scr, int gw, int NW, int lane) {
    int i0 = gw;
    if (i0 >= NWL_FFN) return;
    WcItem A = wc_item(P, i0, wg, wu, wd), B = A; bool hasB = (i0 + NW) < NWL_FFN;
    if (hasB) B = wc_item(P, i0 + NW, wg, wu, wd);
    f32x4 va[8], vb[8];
#pragma unroll
    for (int i = 0; i < 8; ++i) vb[i] = (f32x4){0.f, 0.f, 0.f, 0.f};
    wc_load(A, va, lane); if (hasB) wc_load(B, vb, lane);
    for (;;) {
        const WcItem cA = A, cB = B; const bool cHasB = hasB;
        f32x4 ca[8], cb[8];
#pragma unroll
        for (int i = 0; i < 8; ++i) { ca[i] = va[i]; cb[i] = vb[i]; }
        i0 += 2 * NW;
        const bool more = i0 < NWL_FFN;
        if (more) { A = wc_item(P, i0, wg, wu, wd); hasB = (i0 + NW) < NWL_FFN; if (hasB) B = wc_item(P, i0 + NW, wg, wu, wd);
            wc_load(A, va, lane); if (hasB) wc_load(B, vb, lane); }
        wc_store(cA, ca, scr, lane);
        if (cHasB) wc_store(cB, cb, scr, lane);
        if (!more) break;
    }
}

__device__ __forceinline__ void dn_out_phase(const Params& P) {
    const bf16_t* O = (const bf16_t*)(P.ws + WS_O); const bf16_t* PB = (const bf16_t*)(P.ws + WS_BIG); bf16_t* Y = (bf16_t*)(P.ws + WS_H);
    const int lane = threadIdx.x & 63, wid = threadIdx.x >> 6;
    const int d0 = (lane & 7) * 16;
    float nw[16];
#pragma unroll
    for (int i = 0; i < 16; ++i) nw[i] = P.dn_norm_w[d0 + i];
    const int NW = gridDim.x * 8;
    for (int row0 = blockIdx.x * 8 + wid; row0 < T_TOK; row0 += 2 * NW) {
        f32x4 v[2][4]; u32x4 z[2][2];
#pragma unroll
        for (int r = 0; r < 2; ++r) { const int row = (row0 + r * NW < T_TOK) ? row0 + r * NW : row0;
            const u32x4* op = (const u32x4*)(O + (size_t)row * 1024 + lane * 16);
            const u32x4* zp = (const u32x4*)(PB + (size_t)row * NIN + 5120 + lane * 16);
            const u32x4 q0 = op[0], q1 = op[1];
            v[r][0] = (f32x4){bf_lo(q0.x), bf_hi(q0.x), bf_lo(q0.y), bf_hi(q0.y)}; v[r][1] = (f32x4){bf_lo(q0.z), bf_hi(q0.z), bf_lo(q0.w), bf_hi(q0.w)};
            v[r][2] = (f32x4){bf_lo(q1.x), bf_hi(q1.x), bf_lo(q1.y), bf_hi(q1.y)}; v[r][3] = (f32x4){bf_lo(q1.z), bf_hi(q1.z), bf_lo(q1.w), bf_hi(q1.w)};
            z[r][0] = zp[0]; z[r][1] = zp[1]; }
#pragma unroll
        for (int r = 0; r < 2; ++r) {
            const int row = row0 + r * NW;
            if (row < T_TOK) {
                float ss = 0.f;
#pragma unroll
                for (int i = 0; i < 4; ++i) ss += (v[r][i].x * v[r][i].x + v[r][i].y * v[r][i].y) + (v[r][i].z * v[r][i].z + v[r][i].w * v[r][i].w);
                ss += __shfl_xor(ss, 1); ss += __shfl_xor(ss, 2); ss += __shfl_xor(ss, 4);
                const float rstd = 1.f / sqrtf(ss * (1.f / 128.f) + 1e-6f);
                const unsigned zz[8] = {z[r][0].x, z[r][0].y, z[r][0].z, z[r][0].w, z[r][1].x, z[r][1].y, z[r][1].z, z[r][1].w};
                unsigned w[8];
#pragma unroll
                for (int i = 0; i < 8; ++i) {
                    const float a = v[r][i >> 1][(i & 1) * 2] * rstd * nw[2 * i] * fast_silu(bf_lo(zz[i]));
                    const float bq = v[r][i >> 1][(i & 1) * 2 + 1] * rstd * nw[2 * i + 1] * fast_silu(bf_hi(zz[i]));
                    w[i] = cvt_pk_bf16(a, bq);
                }
                u32x4* yp = (u32x4*)(Y + (size_t)row * DM + 1024 + lane * 16);
                yp[0] = (u32x4){w[0], w[1], w[2], w[3]}; yp[1] = (u32x4){w[4], w[5], w[6], w[7]};
            }
        }
    }
}

__device__ __forceinline__ void final_norm_phase(const Params& P) {
    const bf16_t* X3 = (const bf16_t*)(P.ws + WS_H);
    const int lane = threadIdx.x & 63, wid = threadIdx.x >> 6;
    const int NW = gridDim.x * 8;
    for (int row = blockIdx.x * 8 + wid; row < T_TOK; row += 2 * NW) {
        const int row1 = row + NW; const bool two = row1 < T_TOK;
        const u32x2* xr0 = (const u32x2*)(X3 + (size_t)row * DM) + lane; const u32x2* xr1 = (const u32x2*)(X3 + (size_t)(two ? row1 : row) * DM) + lane;
        u32x2 r0[8], r1[8];
#pragma unroll
        for (int i = 0; i < 8; ++i) { r0[i] = xr0[64 * i]; r1[i] = xr1[64 * i]; }
        f32x4 v0[8], v1[8]; float ss0 = 0.f, ss1 = 0.f;
#pragma unroll
        for (int i = 0; i < 8; ++i) { v0[i] = (f32x4){bf_lo(r0[i].x), bf_hi(r0[i].x), bf_lo(r0[i].y), bf_hi(r0[i].y)}; v1[i] = (f32x4){bf_lo(r1[i].x), bf_hi(r1[i].x), bf_lo(r1[i].y), bf_hi(r1[i].y)};
            ss0 += (v0[i].x * v0[i].x + v0[i].y * v0[i].y) + (v0[i].z * v0[i].z + v0[i].w * v0[i].w);
            ss1 += (v1[i].x * v1[i].x + v1[i].y * v1[i].y) + (v1[i].z * v1[i].z + v1[i].w * v1[i].w); }
#pragma unroll
        for (int o = 1; o < 64; o <<= 1) { const float t0 = __shfl_xor(ss0, o), t1 = __shfl_xor(ss1, o); ss0 += t0; ss1 += t1; }
        const float rstd0 = 1.f / sqrtf(ss0 * (1.f / DM) + 1e-6f), rstd1 = 1.f / sqrtf(ss1 * (1.f / DM) + 1e-6f);
        f32x4* o0 = (f32x4*)(P.out + (size_t)row * DM) + lane; f32x4* o1 = (f32x4*)(P.out + (size_t)(two ? row1 : row) * DM) + lane;
#pragma unroll
        for (int i = 0; i < 8; ++i) { const f32x4 w = *((const f32x4*)P.final_norm + lane + 64 * i); __builtin_nontemporal_store(v0[i] * rstd0 * w, o0 + 64 * i); if (two) __builtin_nontemporal_store(v1[i] * rstd1 * w, o1 + 64 * i); }
    }
}

#define XB_TMO      128
#define XB_XCNT(j)  (256  + 64 * (j))
#define XB_XSUB(j)  (1280 + 64 * (j))
#define XB_XGEN(j)  (2304 + 64 * (j))
#define XB_TOP      3328
#define XB_TOPGEN   3392
#define XCD_BAR_WORDS 3456
#define XB_SPIN_CAP (1u << 22)
__device__ __forceinline__ unsigned xb_ld(unsigned* p)              { return __hip_atomic_load(p, __ATOMIC_RELAXED, __HIP_MEMORY_SCOPE_AGENT); }
__device__ __forceinline__ unsigned xb_add(unsigned* p, unsigned v) { return __hip_atomic_fetch_add(p, v, __ATOMIC_RELAXED, __HIP_MEMORY_SCOPE_AGENT); }
__device__ __forceinline__ unsigned xb_xcc_id() { return (unsigned)__builtin_amdgcn_s_getreg((3 << 11) | 20) & 0xFu; }
#define XB_SPIN(cond, bar) do { unsigned _sp = 0; while (cond) { __builtin_amdgcn_s_sleep(1); \
    if ((++_sp & 255u) == 0u) { if (xb_ld(&(bar)[XB_TMO])) break; if (_sp > XB_SPIN_CAP) { atomicAdd(&(bar)[XB_TMO], 1u); break; } } } } while (0)
struct XcdBarrier { unsigned* bar; unsigned x; volatile LAS unsigned* st; };
__device__ __forceinline__ XcdBarrier xcd_barrier_post(unsigned* bar, volatile LAS unsigned* st) {
    XcdBarrier b; b.bar = bar; b.x = xb_xcc_id(); b.st = st;
    if (threadIdx.x == 0) (void)xb_add(&bar[XB_XCNT(b.x)], 1u);
    return b;
}
__device__ __forceinline__ void xcd_barrier_complete(unsigned* bar, unsigned x, unsigned& nloc, unsigned& nx) {
    const unsigned G = gridDim.x * gridDim.y * gridDim.z;
    unsigned sum, cnt, mine, sp = 0u;
    for (;;) {
        sum = 0u; cnt = 0u; mine = 0u;
#pragma unroll
        for (unsigned j = 0; j < 16; ++j) { const unsigned c = xb_ld(&bar[XB_XCNT(j)]); sum += c; cnt += (c > 0u) ? 1u : 0u; mine = (j == x) ? c : mine; }
        if (sum == G) break;
        __builtin_amdgcn_s_sleep(1);
        if ((++sp & 255u) == 0u) { if (xb_ld(&bar[XB_TMO])) break; if (sp > XB_SPIN_CAP) { atomicAdd(&bar[XB_TMO], 1u); break; } }
    }
    nloc = mine > 0u ? mine : 1u; nx = cnt > 0u ? cnt : 1u;
}
__device__ __forceinline__ void xcd_barrier(const XcdBarrier& b) {
    asm volatile("s_waitcnt vmcnt(0)" ::: "memory");
    __syncthreads();
    if (threadIdx.x == 0) {
        unsigned* bar = b.bar;
        __builtin_amdgcn_s_waitcnt(0);
        unsigned nloc = b.st[0], nx = b.st[1];
        if (nloc == 0u) { xcd_barrier_complete(bar, b.x, nloc, nx); b.st[0] = nloc; b.st[1] = nx; }
        const unsigned old = xb_add(&bar[XB_XSUB(b.x)], 1u);
        const unsigned gen = old / nloc;
        if (old + 1u == (gen + 1u) * nloc) {
            __builtin_amdgcn_fence(__ATOMIC_RELEASE, "agent");
            asm volatile("s_waitcnt vmcnt(0)" ::: "memory");
            const unsigned og = xb_add(&bar[XB_TOP], 1u);
            const unsigned tg = og / nx;
            if (og + 1u == (tg + 1u) * nx) xb_add(&bar[XB_TOPGEN], 1u);
            else XB_SPIN(xb_ld(&bar[XB_TOPGEN]) == tg, bar);
            __builtin_amdgcn_fence(__ATOMIC_ACQUIRE, "agent");
            xb_add(&bar[XB_XGEN(b.x)], 1u);
            asm volatile("s_waitcnt vmcnt(0)" ::: "memory");
        } else {
            XB_SPIN(xb_ld(&bar[XB_XGEN(b.x)]) == gen, bar);
            __builtin_amdgcn_fence(__ATOMIC_ACQUIRE, "agent");
            asm volatile("s_waitcnt vmcnt(0)" ::: "memory");
        }
    }
    __syncthreads();
}

constexpr int N_PHASES = 14;
#ifdef ONLY_PH
#define PH_ON(k) ((k) == ONLY_PH)
#else
#define PH_ON(k) 1
#endif
__global__ void __launch_bounds__(512, 2) fwd_megakernel(Params P) {
    extern __shared__ __attribute__((aligned(16))) unsigned char lds_raw[];
    LAS unsigned char* lds = (LAS unsigned char*)lds_raw;
    const int G = gridDim.x;
    bf16_t* H = (bf16_t*)(P.ws + WS_H); bf16_t* BIG = (bf16_t*)(P.ws + WS_BIG);
    bf16_t* XB = (bf16_t*)P.out;
    const bf16_t* WUP = (const bf16_t*)(P.ws + WS_WUP); const bf16_t* WDN = (const bf16_t*)(P.ws + WS_WDN);
    const bf16_t* WIN = (const bf16_t*)(P.ws + WS_WIN); const bf16_t* WOUT = (const bf16_t*)(P.ws + WS_WOUT);
    const float* mods = (const float*)(P.ws + WS_MODS);
    const int lo = P.ph_lo, hi = P.ph_hi;
    volatile LAS unsigned* xst = (volatile LAS unsigned*)(lds + LDS_BYTES - 16);
    XcdBarrier xbar; xbar.bar = (unsigned*)(P.ws + WS_BAR); xbar.x = 0; xbar.st = xst;
    if (hi - lo > 1) {
        if (threadIdx.x == 0) { xst[0] = 0u; xst[1] = 0u; }
        __syncthreads();
        xbar = xcd_barrier_post((unsigned*)(P.ws + WS_BAR), xst);
    }
    if (lo < 0) cg::this_grid().sync();
#define IN(k) (PH_ON(k) && lo <= (k) && (k) < hi)
#define SEAM(k) do { if (lo <= (k) && (k) + 1 < hi) { for (int _s = 0; _s < PROBE_SYNC_REP; ++_s) { xcd_barrier(xbar); } } } while (0)
#define REPN(k) for (int _r = 0; _r < (((PROBE_REP_MASK >> (k)) & 1) ? 2 : 1); ++_r)
    if (IN(0)) REPN(0) { phase0(P, lds); }
    SEAM(0);
    if (IN(1)) REPN(1) { mods_finalize(P); norm_mod_phase<false>(P, lds, P.x, P.ffn1_norm, 0, true, H); }
    SEAM(1);
    if (IN(2)) REPN(2) { pg8::Gemm g{H, WUP, T_TOK, NUP, DM}; pg8::StaticOrder S; S.init(T_TOK, NUP, G, blockIdx.x, 8); pg8::EpiSwiGLU E{BIG, DFF}; pg8::gemm_phase(lds, g, S, E); }
    SEAM(2);
    if (IN(3)) REPN(3) { pg8::Gemm g{BIG, WDN, T_TOK, DM, DFF}; pg8::StaticOrder S; S.init(T_TOK, DM, G, blockIdx.x); pg8::EpiResidB<false, true> E{P.x, XB, mods + 2 * DM}; pg8::gemm_phase(lds, g, S, E); }
    SEAM(3);
    if (IN(4)) REPN(4) { norm_mod_phase<true>(P, lds, XB, P.mix_norm, 3, false, H); }
    SEAM(4);
    if (IN(5)) REPN(5) { pg8::Gemm g{H, WIN, T_TOK, 6144, DM}; pg8::StaticOrder S; S.init(T_TOK, 6144, G, blockIdx.x); pg8::EpiBf16 E{BIG, NIN}; pg8::gemm_phase(lds, g, S, E); gate_cols_phase(P, lds); }
    SEAM(5);
    if (IN(6)) REPN(6) {
        for (int _p = 0; _p < PROBE_PREP_REP; ++_p) { float gb = 0.f, ga = 0.f; int ch = blockIdx.x;
            if (ch < NCH_TOT) dn_gate_load(P, ch, gb, ga);
            for (; ch < NCH_TOT; ch += G) dn_prep_chunk(P, lds, ch, gb, ga, (ch + G < NCH_TOT) ? ch + G : -1); }
        for (int _p = 0; _p < PROBE_CONV_REP; ++_p) for (int it = blockIdx.x; it < NB * (SEQ / 32); it += G) conv_item(P, lds, it);
    }
    SEAM(6);
    if (IN(7)) REPN(7) {
        const int wv = threadIdx.x >> 6;
        if (wv == 0) { for (int chain = blockIdx.x; chain < 256; chain += G) scan_chain(P, lds, chain); }
        else if (wv >= 3) {
            const int lane = threadIdx.x & 63, gw = blockIdx.x * 5 + (wv - 3), NW = G * 5;
            LAS float* scr = (LAS float*)(lds + SC_CONV + (wv - 3) * SC_CONV_WAVE);
            wc_wave_loop(P, P.ffn2_wg, P.ffn2_wu, P.ffn2_wd, scr, gw, NW, lane);
        }
    }
    SEAM(7);
    if (IN(8)) REPN(8) { dn_out_phase(P); }
    SEAM(8);
    if (IN(9)) { pg8::Gemm g{H, WOUT, T_TOK, DM, DM}; pg8::StaticOrder S; S.init(T_TOK, DM, G, blockIdx.x); pg8::EpiResidB<true, false> E{XB, XB, mods + 5 * DM}; pg8::gemm_phase(lds, g, S, E); }
    SEAM(9);
    if (IN(10)) REPN(10) { norm_mod_phase<true>(P, lds, XB, P.ffn2_norm, 6, false, H); }
    SEAM(10);
    if (IN(11)) REPN(11) { pg8::Gemm g{H, WUP, T_TOK, NUP, DM}; pg8::StaticOrder S; S.init(T_TOK, NUP, G, blockIdx.x, 8); pg8::EpiSwiGLU E{BIG, DFF}; pg8::gemm_phase(lds, g, S, E); }
    SEAM(11);
    if (IN(12)) { pg8::Gemm g{BIG, WDN, T_TOK, DM, DFF}; pg8::StaticOrder S; S.init(T_TOK, DM, G, blockIdx.x); pg8::EpiResidB<true, true> E{XB, H, mods + 8 * DM}; pg8::gemm_phase(lds, g, S, E); }
    SEAM(12);
    if (IN(13)) { final_norm_phase(P); }
#undef IN
#undef SEAM
}

extern "C" void kernel_launch(void* const* d_in, const int* in_sizes, int n_in, void* d_out, int out_size, void* d_ws, size_t ws_size, hipStream_t stream) {
    static int grid = 0;
    if (grid == 0) {
        if (n_in != 24 || out_size != T_TOK * DM || ws_size < WS_END) { fprintf(stderr, "kernel_launch: unexpected shapes (n_in %d out %d ws %zu need %zu)\n", n_in, out_size, ws_size, (size_t)WS_END); grid = -1; return; }
        int dev = 0, cus = 0, per_cu = 0;
        hipGetDevice(&dev); hipDeviceGetAttribute(&cus, hipDeviceAttributeMultiprocessorCount, dev);
        if (hipFuncSetAttribute((const void*)fwd_megakernel, hipFuncAttributeMaxDynamicSharedMemorySize, LDS_BYTES) != hipSuccess) { fprintf(stderr, "kernel_launch: hipFuncSetAttribute failed\n"); grid = -1; return; }
        hipOccupancyMaxActiveBlocksPerMultiprocessor(&per_cu, (const void*)fwd_megakernel, 512, LDS_BYTES);
        if (per_cu < 1) { fprintf(stderr, "kernel_launch: occupancy query says %d\n", per_cu); per_cu = 1; }
        (void)hipGetLastError();
        grid = cus;
    }
    if (grid < 0) return;
    Params p{};
    const float** pp = (const float**)&p;
    for (int i = 0; i < 24; ++i) pp[i] = (const float*)d_in[i];
    p.out = (float*)d_out; p.ws = (unsigned char*)d_ws;
    hipMemsetAsync(d_ws, 0, XCD_BAR_WORDS * 4, stream);
#if MK_MULTI
    for (int ph = 0; ph < N_PHASES; ++ph) { p.ph_lo = ph; p.ph_hi = ph + 1; hipLaunchKernelGGL(fwd_megakernel, dim3(grid), dim3(512), LDS_BYTES, stream, p); }
#else
    p.ph_lo = 0; p.ph_hi = N_PHASES;
    void* args[] = {&p};
    hipError_t e = hipLaunchCooperativeKernel((const void*)fwd_megakernel, dim3(grid), dim3(512), args, LDS_BYTES, stream);
    if (e != hipSuccess) fprintf(stderr, "cooperative launch failed: %s (grid %d)\n", hipGetErrorString(e), grid);
#endif
}
```

```cpp
#include <hip/hip_runtime.h>
#include <hip/hip_cooperative_groups.h>
#include <cstdio>
namespace cg = cooperative_groups;

#ifndef MK_MULTI
#define MK_MULTI 0
#endif

#ifndef PROBE_REP_MASK
#define PROBE_REP_MASK 0
#endif
#ifndef PROBE_PREP_REP
#define PROBE_PREP_REP 1
#endif
#ifndef PROBE_CONV_REP
#define PROBE_CONV_REP 1
#endif
#ifndef PROBE_SYNC_REP
#define PROBE_SYNC_REP 1
#endif
#define LAS __attribute__((address_space(3)))
typedef unsigned short bf16_t;
typedef short bf16x8 __attribute__((ext_vector_type(8)));
typedef float f32x4 __attribute__((ext_vector_type(4)));
typedef float f32x2 __attribute__((ext_vector_type(2)));
typedef unsigned u32x4 __attribute__((ext_vector_type(4)));
typedef unsigned u32x2 __attribute__((ext_vector_type(2)));

constexpr int T_TOK = 16384, DM = 2048, DFF = 5632, NUP = 2 * DFF, SEQ = 4096, NB = 4;
constexpr int NIN_REAL = 6160, NIN = 6400, NMOD = 9 * DM;
constexpr int KS_ADA = 8;
constexpr int NCHUNK = 64, NHEAD = 8, NCH_TOT = NB * NHEAD * NCHUNK;
constexpr int OPS_BYTES = 73728;
constexpr int OPS_W = 0, OPS_Q = 16384, OPS_KT = 32768, OPS_A = 49152, OPS_U = 57344;
constexpr int LDS_BYTES = 163840;

constexpr size_t al256(size_t x) { return (x + 255) & ~(size_t)255; }
constexpr size_t WS_BAR = 0;
constexpr size_t WS_MODP = 16384;
constexpr size_t WS_MODS = al256(WS_MODP + (size_t)KS_ADA * NB * NMOD * 4);
constexpr size_t WS_GL   = al256(WS_MODS + (size_t)NB * NMOD * 4);
constexpr size_t WS_WUP  = al256(WS_GL + (size_t)NCH_TOT * 4);
constexpr size_t WS_WDN  = al256(WS_WUP + (size_t)NUP * DM * 2);
constexpr size_t WS_WIN  = al256(WS_WDN + (size_t)DM * DFF * 2);
constexpr size_t WS_WOUT = al256(WS_WIN + (size_t)NIN * DM * 2);
constexpr size_t WS_H    = al256(WS_WOUT + (size_t)DM * DM * 2);
constexpr size_t WS_BIG  = al256(WS_H + (size_t)T_TOK * DM * 2);
constexpr size_t WS_SCAN = al256(WS_BIG + (size_t)T_TOK * NIN * 2);
constexpr size_t WS_O    = al256(WS_SCAN + (size_t)NCH_TOT * OPS_BYTES);
constexpr size_t WS_END  = al256(WS_O + (size_t)T_TOK * 1024 * 4);

struct Params {
    const float *x, *c, *w_ada, *b_ada, *ffn1_norm, *ffn1_wg, *ffn1_wu, *ffn1_wd, *mix_norm, *w_in, *w_dw, *b_dw, *conv_ln_w, *conv_ln_b,
                *w_short, *a_log, *dt_bias, *dn_norm_w, *w_out, *ffn2_norm, *ffn2_wg, *ffn2_wu, *ffn2_wd, *final_norm;
    float* out; unsigned char* ws;
    int ph_lo, ph_hi;
};

typedef __bf16 bf16x2_t __attribute__((ext_vector_type(2)));
__device__ __forceinline__ unsigned cvt_pk_bf16(float lo, float hi) { const f32x2 v = {lo, hi}; const bf16x2_t r = __builtin_convertvector(v, bf16x2_t); return __builtin_bit_cast(unsigned, r); }
__device__ __forceinline__ float bf_lo(unsigned w) { return __uint_as_float(w << 16); }
__device__ __forceinline__ float bf_hi(unsigned w) { return __uint_as_float(w & 0xffff0000u); }
__device__ __forceinline__ float bf1(bf16_t v) { return __uint_as_float(((unsigned)v) << 16); }
__device__ __forceinline__ float wave_sum(float v) {
#pragma unroll
    for (int o = 1; o < 64; o <<= 1) v += __shfl_xor(v, o);
    return v;
}
#define LDS_BARRIER() do { asm volatile("s_waitcnt lgkmcnt(0)" ::: "memory"); __builtin_amdgcn_s_barrier(); asm volatile("" ::: "memory"); } while (0)
__device__ __forceinline__ float fast_sigmoid(float v) { return __builtin_amdgcn_rcpf(1.f + __builtin_amdgcn_exp2f(-1.44269504f * v)); }
__device__ __forceinline__ float fast_silu(float v) { return v * fast_sigmoid(v); }

namespace pg8 {
constexpr int BM = 256, BK = 64, HALF = 128, HTB = HALF * BK * 2, STAGE_BYTES = 8 * HTB, NXCD = 8, WGM = 4;
__host__ __device__ __forceinline__ int lds_byte(int r, int c) { const int st = (r >> 4) * 2 + (c >> 5), rr = r & 15, cc = c & 31, ob = rr * 64 + cc * 2; return st * 1024 + (ob ^ (((ob >> 9) & 1) << 5)); }
__host__ __device__ __forceinline__ void stage_rc(int b, int& R, int& C) { const int st = b / 1024, sb = b % 1024, swz = sb ^ (((sb >> 9) & 1) << 5); R = (st >> 1) * 16 + swz / 64; C = (st & 1) * 32 + (swz % 64) / 2; }
__host__ __device__ __forceinline__ int perm32(int rho) { const int n = rho >> 4, i = rho & 15; return 8 * (i >> 2) + 4 * n + (i & 3); }
struct Unit { int pm, pn; };
struct Gemm { const bf16_t* A; const bf16_t* Bt; int M, N, K; };
struct StaticOrder {
    int nM, nN, nwg, G, c, wgm;
    __host__ __device__ void init(int M, int N, int G_, int c_, int wgm_ = WGM) { nM = M / BM; nN = N / BM; nwg = nM * nN; G = G_; c = c_; wgm = wgm_; }
    __host__ __device__ bool next(int i, Unit& u) const {
        const long L = (long)i * G + c; if (L >= nwg) return false;
        int wgid = (int)L; { const int q = nwg / NXCD, r = nwg % NXCD, xcd = wgid % NXCD, off = wgid / NXCD; wgid = (xcd < r ? xcd * (q + 1) : r * (q + 1) + (xcd - r) * q) + off; }
        const int nig = wgm * nN, gid = wgid / nig, fm = gid * wgm, gsz = (nM - fm) < wgm ? (nM - fm) : wgm;
        u.pm = fm + ((wgid % nig) % gsz); u.pn = (wgid % nig) / gsz; return true;
    }
};

struct EpiSwiGLU {
    static constexpr bool PERM = true;
    bf16_t* O; int ldc;
    __device__ __forceinline__ void operator()(const f32x4 (&acc)[2][2][4][2], const Unit& u, int wr, int wc, int fr, int fq) const {
        const int row0 = u.pm * BM + wr * 64 + fr, col0 = u.pn * HALF + wc * 32 + 8 * fq;
#pragma unroll
        for (int ai = 0; ai < 2; ++ai)
#pragma unroll
            for (int m = 0; m < 4; ++m) {
                bf16_t* rowp = O + (size_t)(row0 + ai * HALF + m * 16) * ldc + col0;
                float v[8];
#pragma unroll
                for (int n = 0; n < 2; ++n)
#pragma unroll
                    for (int j = 0; j < 4; ++j) { const float g = acc[ai][0][m][n][j], uu = acc[ai][1][m][n][j]; v[n * 4 + j] = fast_silu(g) * uu; }
                u32x4 w; w.x = cvt_pk_bf16(v[0], v[1]); w.y = cvt_pk_bf16(v[2], v[3]); w.z = cvt_pk_bf16(v[4], v[5]); w.w = cvt_pk_bf16(v[6], v[7]);
                *(u32x4*)rowp = w;
            }
    }
};
struct EpiResid {
    static constexpr bool PERM = false;
    const float* base; float* out; const float* gate; float gs;
    __device__ __forceinline__ void operator()(const f32x4 (&acc)[2][2][4][2], const Unit& u, int wr, int wc, int fr, int fq) const {
        const int row0 = u.pm * BM + wr * 64 + fr, col0 = u.pn * BM + wc * 32 + 4 * fq, b = u.pm >> 4;
        f32x4 gv[2][2];
#pragma unroll
        for (int bj = 0; bj < 2; ++bj)
#pragma unroll
            for (int n = 0; n < 2; ++n) gv[bj][n] = *(const f32x4*)(gate + (size_t)b * NMOD + col0 + bj * HALF + n * 16) * gs;
#pragma unroll
        for (int ai = 0; ai < 2; ++ai)
#pragma unroll
            for (int m = 0; m < 4; ++m) {
                const size_t off = (size_t)(row0 + ai * HALF + m * 16) * DM + col0;
#pragma unroll
                for (int bj = 0; bj < 2; ++bj)
#pragma unroll
                    for (int n = 0; n < 2; ++n) { const f32x4 bb = *(const f32x4*)(base + off + bj * HALF + n * 16); *(f32x4*)(out + off + bj * HALF + n * 16) = bb + gv[bj][n] * acc[ai][bj][m][n]; }
            }
    }
};
template <bool BASE_BF16, bool HALFG> struct EpiResidB {
    static constexpr bool PERM = false;
    const void* base; bf16_t* out; const float* gate;
    static constexpr float gs = HALFG ? 0.5f : 1.0f;
    __device__ __forceinline__ void operator()(const f32x4 (&acc)[2][2][4][2], const Unit& u, int wr, int wc, int fr, int fq) const {
        const int row0 = u.pm * BM + wr * 64 + fr, col0 = u.pn * BM + wc * 32 + 4 * fq, b = u.pm >> 4;
        f32x4 gv[2][2];
#pragma unroll
        for (int bj = 0; bj < 2; ++bj)
#pragma unroll
            for (int n = 0; n < 2; ++n) gv[bj][n] = *(const f32x4*)(gate + (size_t)b * NMOD + col0 + bj * HALF + n * 16) * gs;
#pragma unroll
        for (int ai = 0; ai < 2; ++ai) {
            f32x4 bb[4][2][2];
#pragma unroll
            for (int m = 0; m < 4; ++m) {
                const size_t off = (size_t)(row0 + ai * HALF + m * 16) * DM + col0;
#pragma unroll
                for (int bj = 0; bj < 2; ++bj)
#pragma unroll
                    for (int n = 0; n < 2; ++n) {
                        if (BASE_BF16) { const u32x2 r = *(const u32x2*)((const bf16_t*)base + off + bj * HALF + n * 16); bb[m][bj][n] = (f32x4){__uint_as_float(r.x), __uint_as_float(r.y), 0.f, 0.f}; }
                        else bb[m][bj][n] = *(const f32x4*)((const float*)base + off + bj * HALF + n * 16);
                    }
            }
            __builtin_amdgcn_sched_barrier(0);
#pragma unroll
            for (int m = 0; m < 4; ++m) {
                const size_t off = (size_t)(row0 + ai * HALF + m * 16) * DM + col0;
#pragma unroll
                for (int bj = 0; bj < 2; ++bj)
#pragma unroll
                    for (int n = 0; n < 2; ++n) {
                        f32x4 x;
                        if (BASE_BF16) { const unsigned r0 = __float_as_uint(bb[m][bj][n][0]), r1 = __float_as_uint(bb[m][bj][n][1]); x = (f32x4){bf_lo(r0), bf_hi(r0), bf_lo(r1), bf_hi(r1)}; }
                        else x = bb[m][bj][n];
                        const f32x4 xn = x + gv[bj][n] * acc[ai][bj][m][n];
                        u32x2 w; w.x = cvt_pk_bf16(xn[0], xn[1]); w.y = cvt_pk_bf16(xn[2], xn[3]);
                        *(u32x2*)(out + off + bj * HALF + n * 16) = w;
                    }
            }
            __builtin_amdgcn_sched_barrier(0);
        }
    }
};
struct EpiBf16 {
    static constexpr bool PERM = true;
    bf16_t* O; int ldc;
    __device__ __forceinline__ void operator()(const f32x4 (&acc)[2][2][4][2], const Unit& u, int wr, int wc, int fr, int fq) const {
        const int row0 = u.pm * BM + wr * 64 + fr, col0 = u.pn * BM + wc * 32 + 8 * fq;
#pragma unroll
        for (int ai = 0; ai < 2; ++ai)
#pragma unroll
            for (int m = 0; m < 4; ++m) {
                bf16_t* rowp = O + (size_t)(row0 + ai * HALF + m * 16) * ldc + col0;
#pragma unroll
                for (int bj = 0; bj < 2; ++bj) { const f32x4 v0 = acc[ai][bj][m][0], v1 = acc[ai][bj][m][1];
                    u32x4 w; w.x = cvt_pk_bf16(v0[0], v0[1]); w.y = cvt_pk_bf16(v0[2], v0[3]); w.z = cvt_pk_bf16(v1[0], v1[1]); w.w = cvt_pk_bf16(v1[2], v1[3]);
                    *(u32x4*)(rowp + bj * HALF) = w; }
            }
    }
};

template <class Epi>
__device__ __forceinline__ void gemm_phase(LAS unsigned char* lds, const Gemm g, const StaticOrder& S, const Epi& E) {
    const int tid = threadIdx.x, wid = __builtin_amdgcn_readfirstlane(tid >> 6), lane = tid & 63, wr = wid >> 2, wc = wid & 3, fr = lane & 15, fq = lane >> 4;
    const int K = g.K, nt = K / BK;
    unsigned voffA[2], voffB[2];
#pragma unroll
    for (int i = 0; i < 2; ++i) { int R, C; stage_rc(tid * 16 + i * 8192, R, C); const int Rb = Epi::PERM ? ((R & ~31) + perm32(R & 31)) : R;
        voffA[i] = (unsigned)(R * K + C) * 2u; voffB[i] = (unsigned)(Rb * K + C) * 2u; }
    const size_t kstep = (size_t)(BK * 2);
    const size_t hstep = (size_t)HALF * K * 2;
    const size_t tstep = 2 * hstep;
    const unsigned ldsw = (unsigned)wid * 1024u;
    const int aoff = lds_byte(wr * 64 + fr, fq * 8), boff = lds_byte(wc * 32 + fr, fq * 8);
#define PG8_SA(b, h) (((b) * 2 + (h)) * HTB)
#define PG8_SB(b, h) ((4 + (b) * 2 + (h)) * HTB)
#define PG8_STAGE(bufoff, gbase, voff) do { _Pragma("unroll") for (int _i = 0; _i < 2; ++_i) \
        __builtin_amdgcn_global_load_lds((const unsigned*)((const char*)(gbase) + (voff)[_i]), (LAS unsigned*)(lds + (bufoff) + ldsw + _i * 8192), 16, 0, 0); } while (0)
#define PG8_LDA(dst, b, h) do { _Pragma("unroll") for (int m = 0; m < 4; ++m) _Pragma("unroll") for (int k = 0; k < 2; ++k) dst[m][k] = *(const LAS bf16x8*)(lds + PG8_SA(b, h) + aoff + m * 2048 + k * 1024); } while (0)
#define PG8_LDB(dst, b, h) do { _Pragma("unroll") for (int n = 0; n < 2; ++n) _Pragma("unroll") for (int k = 0; k < 2; ++k) dst[n][k] = *(const LAS bf16x8*)(lds + PG8_SB(b, h) + boff + n * 2048 + k * 1024); } while (0)
#define PG8_MMA(ai, bj, At, Bt) do { __builtin_amdgcn_s_setprio(1); _Pragma("unroll") for (int m = 0; m < 4; ++m) _Pragma("unroll") for (int n = 0; n < 2; ++n) _Pragma("unroll") for (int k = 0; k < 2; ++k) \
        acc[ai][bj][m][n] = __builtin_amdgcn_mfma_f32_16x16x32_bf16(Bt[n][k], At[m][k], acc[ai][bj][m][n], 0, 0, 0); __builtin_amdgcn_s_setprio(0); } while (0)
#define PG8_WAIT_V(n) asm volatile("s_waitcnt vmcnt(" #n ")" ::: "memory")
#define PG8_WAIT_L(n) asm volatile("s_waitcnt lgkmcnt(" #n ")" ::: "memory")
#define PG8_BAR __builtin_amdgcn_s_barrier()
#define PG8_SCHED __builtin_amdgcn_sched_barrier(0)
    Unit cur, nxt; int ui = 0;
    if (!S.next(0, cur)) return;
    f32x4 acc[2][2][4][2];
#pragma unroll
    for (int a = 0; a < 2; ++a)
#pragma unroll
        for (int b = 0; b < 2; ++b)
#pragma unroll
            for (int m = 0; m < 4; ++m)
#pragma unroll
                for (int n = 0; n < 2; ++n) acc[a][b][m][n] = (f32x4){0.f, 0.f, 0.f, 0.f};
    bf16x8 At[4][2], B0[2][2], B1[2][2];
    const char* cA = (const char*)g.A + (size_t)cur.pm * tstep; const char* cB = (const char*)g.Bt + (size_t)cur.pn * tstep;
    PG8_STAGE(PG8_SB(0, 0), cB, voffB); PG8_STAGE(PG8_SA(0, 0), cA, voffA); PG8_STAGE(PG8_SB(0, 1), cB + hstep, voffB); PG8_STAGE(PG8_SA(0, 1), cA + hstep, voffA);
    if (wr == 1) PG8_BAR;
    PG8_WAIT_V(4); PG8_BAR;
    PG8_STAGE(PG8_SB(1, 0), cB + kstep, voffB); PG8_STAGE(PG8_SA(1, 0), cA + kstep, voffA); PG8_STAGE(PG8_SB(1, 1), cB + hstep + kstep, voffB);
    PG8_WAIT_V(6); PG8_BAR;
    for (;;) {
        const bool has_next = S.next(ui + 1, nxt);
        const char* nA = has_next ? (const char*)g.A + (size_t)nxt.pm * tstep : cA; const char* nB = has_next ? (const char*)g.Bt + (size_t)nxt.pn * tstep : cB;
        for (int t = 0; t < nt; t += 2) {
            const bool last = (t == nt - 2);
            const char* a1 = cA + (size_t)(t + 1) * kstep;
            const char* a2 = last ? nA : cA + (size_t)(t + 2) * kstep; const char* b2 = last ? nB : cB + (size_t)(t + 2) * kstep;
            const char* a3 = a2 + kstep; const char* b3 = b2 + kstep;
            PG8_LDB(B0, 0, 0); PG8_SCHED; PG8_LDA(At, 0, 0); PG8_STAGE(PG8_SA(1, 1), a1 + hstep, voffA);
            PG8_WAIT_L(8); PG8_BAR; PG8_WAIT_L(0); PG8_MMA(0, 0, At, B0); PG8_BAR; PG8_SCHED;
            PG8_LDB(B1, 0, 1); PG8_STAGE(PG8_SB(0, 0), b2, voffB);
            PG8_BAR; PG8_WAIT_L(0); PG8_MMA(0, 1, At, B1); PG8_BAR;
            PG8_LDA(At, 0, 1); PG8_STAGE(PG8_SA(0, 0), a2, voffA);
            PG8_BAR; PG8_WAIT_L(0); PG8_MMA(1, 0, At, B0); PG8_BAR; PG8_SCHED;
            PG8_STAGE(PG8_SB(0, 1), b2 + hstep, voffB);
            PG8_WAIT_V(6); PG8_BAR; PG8_MMA(1, 1, At, B1); PG8_BAR;
            PG8_LDB(B0, 1, 0); PG8_SCHED; PG8_LDA(At, 1, 0); PG8_STAGE(PG8_SA(0, 1), a2 + hstep, voffA);
            PG8_WAIT_L(8); PG8_BAR; PG8_WAIT_L(0); PG8_MMA(0, 0, At, B0); PG8_BAR; PG8_SCHED;
            PG8_LDB(B1, 1, 1); PG8_STAGE(PG8_SB(1, 0), b3, voffB);
            PG8_BAR; PG8_WAIT_L(0); PG8_MMA(0, 1, At, B1); PG8_BAR;
            PG8_LDA(At, 1, 1); PG8_STAGE(PG8_SA(1, 0), a3, voffA);
            PG8_BAR; PG8_WAIT_L(0); PG8_MMA(1, 0, At, B0); PG8_BAR; PG8_SCHED;
            PG8_STAGE(PG8_SB(1, 1), b3 + hstep, voffB);
            PG8_WAIT_V(6); PG8_BAR; PG8_MMA(1, 1, At, B1); PG8_BAR;
        }
        E(acc, cur, wr, wc, fr, fq);
        if (!has_next) break;
#pragma unroll
        for (int a = 0; a < 2; ++a)
#pragma unroll
            for (int b = 0; b < 2; ++b)
#pragma unroll
                for (int m = 0; m < 4; ++m)
#pragma unroll
                    for (int n = 0; n < 2; ++n) acc[a][b][m][n] = (f32x4){0.f, 0.f, 0.f, 0.f};
        cur = nxt; cA = nA; cB = nB; ++ui;
    }
    PG8_WAIT_V(0);
    if (wr == 0) PG8_BAR;
    PG8_BAR;
#undef PG8_SA
#undef PG8_SB
#undef PG8_STAGE
#undef PG8_LDA
#undef PG8_LDB
#undef PG8_MMA
#undef PG8_WAIT_V
#undef PG8_WAIT_L
#undef PG8_BAR
#undef PG8_SCHED
}
}

__device__ __forceinline__ void gemv_item(const Params& P, LAS unsigned char* lds, int item) {
    const int cgp = item % 72, ks = item / 72;
    const int tid = threadIdx.x, lane = tid & 63, wid = tid >> 6;
    LAS float* sc = (LAS float*)lds;
    LAS float* red = (LAS float*)(lds + 4096);
    for (int i = tid; i < 1024; i += 512) { const int b = i >> 8, kk = i & 255; const float v = P.c[b * DM + ks * 256 + kk]; sc[i] = v / (1.f + __expf(-v)); }
    LDS_BARRIER();
    float acc[4][4];
#pragma unroll
    for (int b = 0; b < 4; ++b)
#pragma unroll
        for (int e = 0; e < 4; ++e) acc[b][e] = 0.f;
    const float* wp = P.w_ada + (size_t)(ks * 256 + wid * 32) * NMOD + cgp * 256 + lane * 4;
    {
        f32x4 wv[32];
#pragma unroll
        for (int r = 0; r < 32; ++r) wv[r] = __builtin_nontemporal_load((const f32x4*)(wp + (size_t)r * NMOD));
        __builtin_amdgcn_sched_barrier(0);
#pragma unroll
        for (int r = 0; r < 32; ++r) {
            const int kk = wid * 32 + r;
#pragma unroll
            for (int b = 0; b < 4; ++b) { const float s = sc[b * 256 + kk];
#pragma unroll
                for (int e = 0; e < 4; ++e) acc[b][e] += s * wv[r][e]; }
        }
    }
#pragma unroll
    for (int b = 0; b < 4; ++b)
#pragma unroll
        for (int e = 0; e < 4; ++e) red[(wid * 16 + b * 4 + e) * 64 + lane] = acc[b][e];
    LDS_BARRIER();
    float* modp = (float*)(P.ws + WS_MODP);
    for (int o = tid; o < 1024; o += 512) { const int be = o >> 6, ln = o & 63; float s = 0.f;
#pragma unroll
        for (int w = 0; w < 8; ++w) s += red[(w * 16 + be) * 64 + ln];
        const int b = be >> 2, e = be & 3; modp[((size_t)ks * NB + b) * NMOD + cgp * 256 + ln * 4 + e] = s; }
    LDS_BARRIER();
}
__device__ __forceinline__ void wconv_tile(const float* W, int N, int k0, int n0, bf16_t* Bt, int Kd, int mode, LAS unsigned char* lds) {
    LAS float* tile = (LAS float*)lds;
    const int tid = threadIdx.x, col = tid & 255, rh = tid >> 8;
    float v[32];
    const bool ok = (n0 + col) < N;
    const float* src = W + (size_t)(k0 + rh) * N + n0 + col;
#pragma unroll
    for (int i = 0; i < 32; ++i) v[i] = ok ? __builtin_nontemporal_load(src + (size_t)(2 * i) * N) : 0.f;
#pragma unroll
    for (int i = 0; i < 32; ++i) tile[(2 * i + rh) * 257 + col] = v[i];
    LDS_BARRIER();
#pragma unroll
    for (int i = 0; i < 4; ++i) {
        const int o = tid + 512 * i, kg = o & 7, n = o >> 3;
        float f[8];
#pragma unroll
        for (int j = 0; j < 8; ++j) f[j] = tile[(8 * kg + j) * 257 + n];
        u32x4 w; w.x = cvt_pk_bf16(f[0], f[1]); w.y = cvt_pk_bf16(f[2], f[3]); w.z = cvt_pk_bf16(f[4], f[5]); w.w = cvt_pk_bf16(f[6], f[7]);
        const int nc = n0 + n;
        const int R = (mode == 0) ? nc : (256 * (nc >> 7) + (nc & 127) + (mode == 2 ? 128 : 0));
        *(u32x4*)(Bt + (size_t)R * Kd + k0 + 8 * kg) = w;
    }
    LDS_BARRIER();
}
constexpr int NT_FFN = 3 * 704, NT_WIN = 800, NT_WOUT = 256;
__device__ __forceinline__ void wconv_ffn_item(const Params& P, LAS unsigned char* lds, int i, const float* wg, const float* wu, const float* wd) {
    bf16_t* WUP = (bf16_t*)(P.ws + WS_WUP); bf16_t* WDN = (bf16_t*)(P.ws + WS_WDN);
    if (i < 704) wconv_tile(wg, DFF, (i / 22) * 64, (i % 22) * 256, WUP, DM, 1, lds);
    else if (i < 1408) { i -= 704; wconv_tile(wu, DFF, (i / 22) * 64, (i % 22) * 256, WUP, DM, 2, lds); }
    else { i -= 1408; wconv_tile(wd, DM, (i / 8) * 64, (i % 8) * 256, WDN, DFF, 0, lds); }
}
__device__ __forceinline__ void phase0(const Params& P, LAS unsigned char* lds) {
    constexpr int N_GEMV = 72 * KS_ADA;
    constexpr int NITEMS = N_GEMV + NT_FFN + NT_WIN + NT_WOUT;
    for (int it = blockIdx.x; it < NITEMS; it += gridDim.x) {
        int i = it;
        if (i < N_GEMV) { gemv_item(P, lds, i); continue; } i -= N_GEMV;
        if (i < NT_FFN) { wconv_ffn_item(P, lds, i, P.ffn1_wg, P.ffn1_wu, P.ffn1_wd); continue; } i -= NT_FFN;
        if (i < NT_WIN) { wconv_tile(P.w_in, NIN_REAL, (i / 25) * 64, (i % 25) * 256, (bf16_t*)(P.ws + WS_WIN), DM, 0, lds); continue; } i -= NT_WIN;
        wconv_tile(P.w_out, DM, (i / 8) * 64, (i % 8) * 256, (bf16_t*)(P.ws + WS_WOUT), DM, 0, lds);
    }
}

template <bool IN_BF16> __device__ __forceinline__ void norm_mod_phase(const Params& P, LAS unsigned char* lds, const void* xin_, const float* normw, int idx, bool from_partials, bf16_t* hout) {
    LAS float* As = (LAS float*)lds; LAS float* Bs = As + DM;
    const int tid = threadIdx.x, lane = tid & 63, wid = tid >> 6;
    const float* modp = (const float*)(P.ws + WS_MODP); const float* mods = (const float*)(P.ws + WS_MODS);
    for (int rb = blockIdx.x; rb < T_TOK / 64; rb += gridDim.x) {
        const int b = rb >> 6;
        __syncthreads();
        for (int k = tid; k < DM; k += 512) {
            float sh, sc;
            if (from_partials) {
                sh = P.b_ada[idx * DM + k]; sc = P.b_ada[(idx + 1) * DM + k];
#pragma unroll
                for (int s = 0; s < KS_ADA; ++s) { sh += modp[((size_t)s * NB + b) * NMOD + idx * DM + k]; sc += modp[((size_t)s * NB + b) * NMOD + (idx + 1) * DM + k]; }
            } else { sh = mods[(size_t)b * NMOD + idx * DM + k]; sc = mods[(size_t)b * NMOD + (idx + 1) * DM + k]; }
            As[k] = normw[k] * (1.f + sc); Bs[k] = sh;
        }
        __syncthreads();
        for (int rr = wid; rr < 64; rr += 16) {
            const int row0 = rb * 64 + rr, row1 = row0 + 8;
            f32x4 v0[8], v1[8]; float ss0 = 0.f, ss1 = 0.f;
            if (IN_BF16) {
                const u32x2* xr0 = (const u32x2*)((const bf16_t*)xin_ + (size_t)row0 * DM) + lane; const u32x2* xr1 = (const u32x2*)((const bf16_t*)xin_ + (size_t)row1 * DM) + lane;
                u32x2 r0[8], r1[8];
#pragma unroll
                for (int i = 0; i < 8; ++i) { r0[i] = xr0[64 * i]; r1[i] = xr1[64 * i]; }
#pragma unroll
                for (int i = 0; i < 8; ++i) { v0[i] = (f32x4){bf_lo(r0[i].x), bf_hi(r0[i].x), bf_lo(r0[i].y), bf_hi(r0[i].y)}; v1[i] = (f32x4){bf_lo(r1[i].x), bf_hi(r1[i].x), bf_lo(r1[i].y), bf_hi(r1[i].y)}; }
            } else {
                const f32x4* xr0 = (const f32x4*)((const float*)xin_ + (size_t)row0 * DM) + lane; const f32x4* xr1 = (const f32x4*)((const float*)xin_ + (size_t)row1 * DM) + lane;
#pragma unroll
                for (int i = 0; i < 8; ++i) { v0[i] = xr0[64 * i]; v1[i] = xr1[64 * i]; }
            }
#pragma unroll
            for (int i = 0; i < 8; ++i) { ss0 += (v0[i].x * v0[i].x + v0[i].y * v0[i].y) + (v0[i].z * v0[i].z + v0[i].w * v0[i].w);
                                          ss1 += (v1[i].x * v1[i].x + v1[i].y * v1[i].y) + (v1[i].z * v1[i].z + v1[i].w * v1[i].w); }
#pragma unroll
            for (int o = 1; o < 64; o <<= 1) { const float t0 = __shfl_xor(ss0, o), t1 = __shfl_xor(ss1, o); ss0 += t0; ss1 += t1; }
            const float rstd0 = 1.f / sqrtf(ss0 * (1.f / DM) + 1e-6f), rstd1 = 1.f / sqrtf(ss1 * (1.f / DM) + 1e-6f);
            u32x2* o80 = (u32x2*)(hout + (size_t)row0 * DM) + lane; u32x2* o81 = (u32x2*)(hout + (size_t)row1 * DM) + lane;
#pragma unroll
            for (int i = 0; i < 8; ++i) { const int k = (lane + 64 * i) * 4;
                const f32x4 a = *(const LAS f32x4*)(As + k), bb = *(const LAS f32x4*)(Bs + k);
                const f32x4 p0 = v0[i] * rstd0 * a + bb, p1 = v1[i] * rstd1 * a + bb;
                u32x2 w; w.x = cvt_pk_bf16(p0.x, p0.y); w.y = cvt_pk_bf16(p0.z, p0.w); o80[64 * i] = w;
                w.x = cvt_pk_bf16(p1.x, p1.y); w.y = cvt_pk_bf16(p1.z, p1.w); o81[64 * i] = w; }
        }
    }
}
__device__ __forceinline__ void mods_finalize(const Params& P) {
    const float* modp = (const float*)(P.ws + WS_MODP); float* mods = (float*)(P.ws + WS_MODS);
    for (int i = blockIdx.x * 512 + threadIdx.x; i < NB * NMOD; i += gridDim.x * 512) {
        const int b = i / NMOD, col = i % NMOD; float s = P.b_ada[col];
#pragma unroll
        for (int ks = 0; ks < KS_ADA; ++ks) s += modp[((size_t)ks * NB + b) * NMOD + col];
        mods[i] = s;
    }
}

__device__ __forceinline__ void gate_cols_phase(const Params& P, LAS unsigned char* lds) {
    const bf16_t* Hh = (const bf16_t*)(P.ws + WS_H); const bf16_t* WINp = (const bf16_t*)(P.ws + WS_WIN); bf16_t* PB = (bf16_t*)(P.ws + WS_BIG);
    const int tid = threadIdx.x, lane = tid & 63, wid = tid >> 6, fr = lane & 15, fq = lane >> 4, mt = wid & 3, kh = wid >> 2;
    LAS f32x4* part = (LAS f32x4*)lds;
    for (int rb = blockIdx.x; rb < T_TOK / 64; rb += gridDim.x) {
        const bf16_t* ap = Hh + (size_t)(rb * 64 + 16 * mt + fr) * DM + kh * 1024 + 8 * fq;
        const bf16_t* bp = WINp + (size_t)(6144 + fr) * DM + kh * 1024 + 8 * fq;
        f32x4 acc = (f32x4){0.f, 0.f, 0.f, 0.f};
#pragma unroll 1
        for (int k0 = 0; k0 < 32; k0 += 8) {
            bf16x8 a[8], b[8];
#pragma unroll
            for (int i = 0; i < 8; ++i) { a[i] = *(const bf16x8*)(ap + (k0 + i) * 32); b[i] = *(const bf16x8*)(bp + (k0 + i) * 32); }
#pragma unroll
            for (int i = 0; i < 8; ++i) acc = __builtin_amdgcn_mfma_f32_16x16x32_bf16(a[i], b[i], acc, 0, 0, 0);
        }
        LDS_BARRIER();
        if (kh == 1) part[mt * 64 + lane] = acc;
        LDS_BARRIER();
        if (kh == 0) {
            acc += part[mt * 64 + lane];
            bf16_t* op = PB + (size_t)(rb * 64 + 16 * mt + 4 * fq) * NIN + 6144 + fr;
#pragma unroll
            for (int j = 0; j < 4; ++j) op[(size_t)j * NIN] = (bf16_t)(cvt_pk_bf16(acc[j], 0.f) & 0xffffu);
        }
    }
}

__device__ __forceinline__ void conv_item(const Params& P, LAS unsigned char* lds, int item) {
    const bf16_t* PB = (const bf16_t*)(P.ws + WS_BIG); bf16_t* Y = (bf16_t*)(P.ws + WS_H);
    const int tid = threadIdx.x;
    const int b = item >> 7, t0 = (item & 127) * 32, ch = tid * 2;
    LAS unsigned* hs = (LAS unsigned*)lds + tid;
    LAS float* ps = (LAS float*)lds;
    LAS float* stat = (LAS float*)(lds + 131072);
    const bf16_t* colp = PB + (size_t)b * SEQ * NIN + ch;
#pragma unroll 1
    for (int j0 = 0; j0 < 64; j0 += 16) {
        unsigned ra[16], rg[16];
#pragma unroll
        for (int jj = 0; jj < 16; ++jj) { const int j = j0 + jj, tt = t0 - 30 + j, tc = tt < 0 ? 0 : (j < 62 ? tt : t0);
            const bf16_t* rp = colp + (size_t)tc * NIN; ra[jj] = *(const unsigned*)rp; rg[jj] = *(const unsigned*)(rp + 1024); }
#pragma unroll
        for (int jj = 0; jj < 16; ++jj) { const int j = j0 + jj, tt = t0 - 30 + j;
            float h0 = bf_lo(ra[jj]) * fast_sigmoid(bf_lo(rg[jj])), h1 = bf_hi(ra[jj]) * fast_sigmoid(bf_hi(rg[jj]));
            const bool ok = (tt >= 0) && (j < 62);
            h0 = ok ? h0 : 0.f; h1 = ok ? h1 : 0.f;
            if (j < 63) hs[j * 512] = cvt_pk_bf16(h0, h1); }
    }
    float acc0[32], acc1[32];
#pragma unroll
    for (int i = 0; i < 32; ++i) { acc0[i] = 0.f; acc1[i] = 0.f; }
#pragma unroll 1
    for (int g = 0; g < 8; ++g) {
        f32x2 w[4];
#pragma unroll
        for (int t = 0; t < 4; ++t) { const int tap = 4 * g + t; w[t] = *(const f32x2*)(P.w_dw + (tap < 31 ? tap : 30) * 1024 + ch); if (tap >= 31) w[t] = (f32x2){0.f, 0.f}; }
        const LAS unsigned* hp = hs + g * 4 * 512;
        float hl[35], hh[35];
#pragma unroll
        for (int r = 0; r < 35; ++r) { const unsigned hv = hp[r * 512]; hl[r] = bf_lo(hv); hh[r] = bf_hi(hv); }
#pragma unroll
        for (int i = 0; i < 32; ++i)
#pragma unroll
            for (int t = 0; t < 4; ++t) { acc0[i] += w[t].x * hl[i + t]; acc1[i] += w[t].y * hh[i + t]; }
    }
    const f32x2 bd = *(const f32x2*)(P.b_dw + ch);
    LDS_BARRIER();
#pragma unroll
    for (int i = 0; i < 32; ++i) {
        acc0[i] += bd.x; acc1[i] += bd.y;
        ps[i * 512 + tid] = acc0[i] + acc1[i];
        ps[16384 + i * 512 + tid] = acc0[i] * acc0[i] + acc1[i] * acc1[i];
    }
    LDS_BARRIER();
    {
        const int tok = tid >> 4, part = tid & 15;
        float s = 0.f, q = 0.f;
#pragma unroll
        for (int k = 0; k < 8; ++k) { const int off = tok * 512 + part * 32 + ((k + part) & 7) * 4;
            const f32x4 a = *(const LAS f32x4*)(ps + off), c = *(const LAS f32x4*)(ps + 16384 + off);
            s += (a[0] + a[1]) + (a[2] + a[3]); q += (c[0] + c[1]) + (c[2] + c[3]); }
#pragma unroll
        for (int o = 1; o < 16; o <<= 1) { s += __shfl_xor(s, o); q += __shfl_xor(q, o); }
        if (part == 0) { const float mu = s * (1.f / 1024.f), var = fmaxf(q * (1.f / 1024.f) - mu * mu, 0.f);
            stat[tok * 2] = mu; stat[tok * 2 + 1] = 1.f / sqrtf(var + 1e-6f); }
    }
    LDS_BARRIER();
    const f32x2 lw = *(const f32x2*)(P.conv_ln_w + ch), lb = *(const f32x2*)(P.conv_ln_b + ch);
    bf16_t* yp = Y + (size_t)(b * SEQ + t0) * DM + ch;
#pragma unroll
    for (int i = 0; i < 32; ++i) {
        const float mu = stat[i * 2], rstd = stat[i * 2 + 1];
        const float y0 = (acc0[i] - mu) * rstd * lw.x + lb.x, y1 = (acc1[i] - mu) * rstd * lw.y + lb.y;
        *(unsigned*)(yp + (size_t)i * DM) = cvt_pk_bf16(fast_silu(y0), fast_silu(y1));
    }
    LDS_BARRIER();
}

constexpr int PL_KH = 0, PL_QH = 17408, PL_RHS = 34816, PL_LM = 100352, PL_G = 117760, PL_BETA = 118016, PL_END = 118272;
constexpr int KH_STRIDE = 272;
constexpr int LM_STRIDE = 68;

__device__ __forceinline__ void dn_gate_load(const Params& P, int ch, float& gb, float& ga) {
    const bf16_t* PB = (const bf16_t*)(P.ws + WS_BIG);
    const int bh = ch >> 6, n = ch & 63, b = bh >> 3, h = bh & 7;
    const bf16_t* rp = PB + ((size_t)b * SEQ + n * 64 + (threadIdx.x & 63)) * NIN + 6144 + h;
    gb = bf1(rp[0]); ga = bf1(rp[8]);
}
__device__ __forceinline__ void dn_prep_chunk(const Params& P, LAS unsigned char* lds, int ch, float& gb, float& ga, int ch_next) {
    const bf16_t* PB = (const bf16_t*)(P.ws + WS_BIG);
    unsigned char* ops = P.ws + WS_SCAN + (size_t)ch * OPS_BYTES;
    const int tid = threadIdx.x, lane = tid & 63, wid = tid >> 6;
    const int bh = ch >> 6, n = ch & 63, b = bh >> 3, h = bh & 7;
    const size_t tok0 = (size_t)b * SEQ + n * 64;
    LAS float* Gs = (LAS float*)(lds + PL_G); LAS float* Bes = (LAS float*)(lds + PL_BETA);
    LAS float* RHS = (LAS float*)(lds + PL_RHS); LAS float* LM = (LAS float*)(lds + PL_LM);
    const int r0 = 4 * (tid >> 5), d4 = 4 * (tid & 31);
    u32x2 raw[3][7];
#pragma unroll
    for (int X = 0; X < 3; ++X)
#pragma unroll
        for (int j = 0; j < 7; ++j) {
            const int tl = n * 64 + r0 - 3 + j, tlc = tl < 0 ? 0 : tl;
            const u32x2 v = *(const u32x2*)(PB + ((size_t)b * SEQ + tlc) * NIN + 2048 + 1024 * X + h * 128 + d4);
            raw[X][j].x = tl >= 0 ? v.x : 0u; raw[X][j].y = tl >= 0 ? v.y : 0u;
        }
    if (wid == 0) {
        const float braw = gb, araw = ga;
        if (ch_next >= 0) dn_gate_load(P, ch_next, gb, ga);
        const float beta = 1.f / (1.f + __expf(-braw));
        const float xx = araw + P.dt_bias[h];
        const float sp = (xx > 20.f) ? xx : log1pf(__expf(xx));
        float g = -__expf(P.a_log[h]) * sp;
#pragma unroll
        for (int o = 1; o < 64; o <<= 1) { const float t = __shfl_up(g, o); if (lane >= o) g += t; }
        Gs[lane] = g; Bes[lane] = beta;
        if (lane == 63) ((float*)(P.ws + WS_GL))[ch] = __expf(g);
    }
    LDS_BARRIER();
    {
        const float Glast = Gs[63];
        float Gr[4], ber[4];
#pragma unroll
        for (int i = 0; i < 4; ++i) { Gr[i] = Gs[r0 + i]; ber[i] = Bes[r0 + i]; }
        float val[3][4][4];
#pragma unroll
        for (int X = 0; X < 3; ++X) {
            const int chX = 1024 * X + h * 128 + d4;
            f32x4 wt[4];
#pragma unroll
            for (int j = 0; j < 4; ++j) wt[j] = *(const f32x4*)(P.w_short + j * 3072 + chX);
            f32x4 xin[7];
#pragma unroll
            for (int j = 0; j < 7; ++j) xin[j] = (f32x4){bf_lo(raw[X][j].x), bf_hi(raw[X][j].x), bf_lo(raw[X][j].y), bf_hi(raw[X][j].y)};
#pragma unroll
            for (int i = 0; i < 4; ++i) {
                f32x4 s = wt[0] * xin[i] + wt[1] * xin[i + 1] + wt[2] * xin[i + 2] + wt[3] * xin[i + 3];
#pragma unroll
                for (int e = 0; e < 4; ++e) val[X][i][e] = fast_silu(s[e]);
            }
        }
        {
            float ss[8];
#pragma unroll
            for (int v = 0; v < 8; ++v) { const int X = v >> 2, i = v & 3;
                ss[v] = (val[X][i][0] * val[X][i][0] + val[X][i][1] * val[X][i][1]) + (val[X][i][2] * val[X][i][2] + val[X][i][3] * val[X][i][3]); }
#pragma unroll
            for (int o = 1; o < 32; o <<= 1) {
                float t[8];
#pragma unroll
                for (int v = 0; v < 8; ++v) t[v] = __shfl_xor(ss[v], o);
#pragma unroll
                for (int v = 0; v < 8; ++v) ss[v] += t[v];
            }
#pragma unroll
            for (int v = 0; v < 8; ++v) { const int X = v >> 2, i = v & 3;
                const float sc = __builtin_amdgcn_rsqf(ss[v] + 1e-6f) * (X == 0 ? 0.08838834764831845f : 1.f);
#pragma unroll
                for (int e = 0; e < 4; ++e) val[X][i][e] *= sc; }
        }
        const int kb = d4 >> 5, hi = (d4 >> 4) & 1, fqd = (d4 >> 2) & 3;
#pragma unroll
        for (int i = 0; i < 4; ++i) {
            const int r = r0 + i;
            u32x2 w;
            w.x = cvt_pk_bf16(val[1][i][0], val[1][i][1]); w.y = cvt_pk_bf16(val[1][i][2], val[1][i][3]);
            *(LAS u32x2*)(lds + PL_KH + r * KH_STRIDE + d4 * 2) = w;
            w.x = cvt_pk_bf16(val[0][i][0], val[0][i][1]); w.y = cvt_pk_bf16(val[0][i][2], val[0][i][3]);
            *(LAS u32x2*)(lds + PL_QH + r * KH_STRIDE + d4 * 2) = w;
            const float be = ber[i], beg = be * __expf(Gr[i]);
            *(LAS f32x4*)(RHS + r * 256 + d4) = (f32x4){val[2][i][0] * be, val[2][i][1] * be, val[2][i][2] * be, val[2][i][3] * be};
            *(LAS f32x4*)(RHS + r * 256 + 128 + d4) = (f32x4){val[1][i][0] * beg, val[1][i][1] * beg, val[1][i][2] * beg, val[1][i][3] * beg};
            const float eg = __expf(Gr[i]);
            w.x = cvt_pk_bf16(val[0][i][0] * eg, val[0][i][1] * eg); w.y = cvt_pk_bf16(val[0][i][2] * eg, val[0][i][3] * eg);
            const int mt = r >> 4, fr = r & 15;
            *(u32x2*)(ops + OPS_Q + ((mt * 4 + kb) * 64 + fqd * 16 + fr) * 16 + hi * 8) = w;
        }
        float ek[4];
#pragma unroll
        for (int i = 0; i < 4; ++i) ek[i] = __expf(Glast - Gr[i]);
        const int kb2 = r0 >> 5, hi2 = (r0 >> 4) & 1, fq2 = (r0 >> 2) & 3;
#pragma unroll
        for (int e = 0; e < 4; ++e) {
            const int d = d4 + e, dt = d >> 4, fr2 = d & 15;
            u32x2 w; w.x = cvt_pk_bf16(val[1][0][e] * ek[0], val[1][1][e] * ek[1]); w.y = cvt_pk_bf16(val[1][2][e] * ek[2], val[1][3][e] * ek[3]);
            *(u32x2*)(ops + OPS_KT + ((dt * 2 + kb2) * 64 + fq2 * 16 + fr2) * 16 + hi2 * 8) = w;
        }
    }
    LDS_BARRIER();
    {
        const int fr = lane & 15, fq = lane >> 4;
        for (int job = wid; job < 26; job += 8) {
            int ct, st; bool isL;
            if (job < 10) { isL = true; int j = job; ct = 0; while (j > ct) { j -= ct + 1; ++ct; } st = j; }
            else { isL = false; const int j = job - 10; ct = j >> 2; st = j & 3; }
            if (isL) {
                f32x4 acc = (f32x4){0.f, 0.f, 0.f, 0.f};
                bf16x8 fa[4], fbb[4];
#pragma unroll
                for (int kb = 0; kb < 4; ++kb) { fa[kb] = *(const LAS bf16x8*)(lds + PL_KH + (16 * ct + fr) * KH_STRIDE + kb * 64 + fq * 16);
                    fbb[kb] = *(const LAS bf16x8*)(lds + PL_KH + (16 * st + fr) * KH_STRIDE + kb * 64 + fq * 16); }
                __builtin_amdgcn_sched_barrier(0);
#pragma unroll
                for (int kb = 0; kb < 4; ++kb) acc = __builtin_amdgcn_mfma_f32_16x16x32_bf16(fa[kb], fbb[kb], acc, 0, 0, 0);
                const int s = 16 * st + fr; const float Gsv = Gs[s];
#pragma unroll
                for (int j = 0; j < 4; ++j) { const int c = 16 * ct + 4 * fq + j;
                    const float v = (c > s) ? Bes[c] * acc[j] * __expf(Gs[c] - Gsv) : 0.f;
                    LM[c * LM_STRIDE + s] = v; }
            } else {
                u32x2 w; w.x = 0u; w.y = 0u;
                if (ct >= st) {
                    f32x4 acc = (f32x4){0.f, 0.f, 0.f, 0.f};
                    bf16x8 fa[4], fbb[4];
#pragma unroll
                    for (int kb = 0; kb < 4; ++kb) { fa[kb] = *(const LAS bf16x8*)(lds + PL_KH + (16 * st + fr) * KH_STRIDE + kb * 64 + fq * 16);
                        fbb[kb] = *(const LAS bf16x8*)(lds + PL_QH + (16 * ct + fr) * KH_STRIDE + kb * 64 + fq * 16); }
                    __builtin_amdgcn_sched_barrier(0);
#pragma unroll
                    for (int kb = 0; kb < 4; ++kb) acc = __builtin_amdgcn_mfma_f32_16x16x32_bf16(fa[kb], fbb[kb], acc, 0, 0, 0);
                    const int c = 16 * ct + fr; const float Gc = Gs[c];
                    float v[4];
#pragma unroll
                    for (int j = 0; j < 4; ++j) { const int s = 16 * st + 4 * fq + j; v[j] = (c >= s) ? acc[j] * __expf(Gc - Gs[s]) : 0.f; }
                    w.x = cvt_pk_bf16(v[0], v[1]); w.y = cvt_pk_bf16(v[2], v[3]);
                }
                *(u32x2*)(ops + OPS_A + ((ct * 2 + (st >> 1)) * 64 + fq * 16 + fr) * 16 + (st & 1) * 8) = w;
            }
        }
    }
    LDS_BARRIER();
    if (tid < 256) {
        LAS float* lmb = LM; asm volatile("" : "+v"(lmb));
        LAS float* rhb = RHS + tid;
        float sol[64];
        f32x4 lb[2][16];
        float rv[2];
        rv[0] = rhb[0];
#pragma unroll
        for (int c = 0; c < 64; ++c) {
            if (c + 1 < 64) {
                rv[(c + 1) & 1] = rhb[(c + 1) * 256];
#pragma unroll
                for (int s4 = 0; s4 < (c + 4) / 4; ++s4) lb[(c + 1) & 1][s4] = *(const LAS f32x4*)(lmb + (c + 1) * LM_STRIDE + 4 * s4);
            }
            float xq[4] = {rv[c & 1], 0.f, 0.f, 0.f};
#pragma unroll
            for (int s4 = 0; s4 < (c + 3) / 4; ++s4) {
                const f32x4 l = lb[c & 1][s4];
#pragma unroll
                for (int e = 0; e < 4; ++e) if (4 * s4 + e < c) xq[e] -= l[e] * sol[4 * s4 + e];
            }
            sol[c] = (xq[0] + xq[1]) + (xq[2] + xq[3]);
        }
#pragma unroll
        for (int c = 0; c < 64; ++c) rhb[c * 256] = sol[c];
    }
    LDS_BARRIER();
#pragma unroll
    for (int i = 0; i < 2; ++i) {
        const int item = tid + 512 * i, f = item >> 6, ln = item & 63, fr = ln & 15, fq = ln >> 4, mt = f >> 2, kb = f & 3;
        const int c = 16 * mt + fr, dk = 32 * kb + 4 * fq;
        const f32x4 a = *(const LAS f32x4*)(RHS + c * 256 + 128 + dk), bb = *(const LAS f32x4*)(RHS + c * 256 + 128 + dk + 16);
        u32x4 w; w.x = cvt_pk_bf16(-a.x, -a.y); w.y = cvt_pk_bf16(-a.z, -a.w); w.z = cvt_pk_bf16(-bb.x, -bb.y); w.w = cvt_pk_bf16(-bb.z, -bb.w);
        *(u32x4*)(ops + OPS_W + item * 16) = w;
    }
#pragma unroll
    for (int i = 0; i < 2; ++i) {
        const int item = tid + 512 * i, f = item >> 6, ln = item & 63, fr = ln & 15, fq = ln >> 4, ds = f >> 1, mp = f & 1;
        float v[8];
#pragma unroll
        for (int j = 0; j < 4; ++j) { v[j] = RHS[(32 * mp + 4 * fq + j) * 256 + 16 * ds + fr]; v[4 + j] = RHS[(32 * mp + 16 + 4 * fq + j) * 256 + 16 * ds + fr]; }
        u32x4 w; w.x = cvt_pk_bf16(v[0], v[1]); w.y = cvt_pk_bf16(v[2], v[3]); w.z = cvt_pk_bf16(v[4], v[5]); w.w = cvt_pk_bf16(v[6], v[7]);
        *(u32x4*)(ops + OPS_U + item * 16) = w;
    }
    LDS_BARRIER();
}

__device__ __forceinline__ void scan_issue(LAS unsigned char* buf, const unsigned char* ops, int lane) {
#pragma unroll
    for (int f = 0; f < 56; ++f)
        __builtin_amdgcn_global_load_lds((const unsigned*)(ops + f * 1024 + lane * 16), (LAS unsigned*)(buf + f * 1024), 16, 0, 0);
}
__device__ __forceinline__ bf16x8 pack8(const f32x4 a, const f32x4 b) {
    u32x4 w; w.x = cvt_pk_bf16(a[0], a[1]); w.y = cvt_pk_bf16(a[2], a[3]); w.z = cvt_pk_bf16(b[0], b[1]); w.w = cvt_pk_bf16(b[2], b[3]);
    return __builtin_bit_cast(bf16x8, w);
}
__device__ __forceinline__ void scan_chain(const Params& P, LAS unsigned char* lds, int chain) {
    const int lane = threadIdx.x & 63, fr = lane & 15, fq = lane >> 4;
    const int xcd = chain & 7, idx = chain >> 3, ds = idx & 7, bh = xcd + 8 * (idx >> 3), b = bh >> 3, h = bh & 7;
    const unsigned char* ops0 = P.ws + WS_SCAN + (size_t)(bh * 64) * OPS_BYTES;
    bf16_t* O = (bf16_t*)(P.ws + WS_O);
    LAS float* OT = (LAS float*)(lds + 2 * 57344);
    float glall = ((const float*)(P.ws + WS_GL))[bh * 64 + lane];
    f32x4 S[8]; bf16x8 Sb[4];
#pragma unroll
    for (int i = 0; i < 8; ++i) S[i] = (f32x4){0.f, 0.f, 0.f, 0.f};
#pragma unroll
    for (int i = 0; i < 4; ++i) Sb[i] = (bf16x8){0, 0, 0, 0, 0, 0, 0, 0};
    scan_issue(lds, ops0, lane);
    u32x4 Un[2];
    Un[0] = *(const u32x4*)(ops0 + OPS_U + ((ds * 2 + 0) * 64 + lane) * 16); Un[1] = *(const u32x4*)(ops0 + OPS_U + ((ds * 2 + 1) * 64 + lane) * 16);
    for (int n = 0; n < 64; ++n) {
        asm volatile("s_waitcnt vmcnt(0)" ::: "memory");
        __builtin_amdgcn_sched_barrier(0);
        asm volatile("" : "+v"(Un[0]), "+v"(Un[1]), "+v"(glall));
        const u32x4 U0 = Un[0], U1 = Un[1];
        const float egl = __builtin_bit_cast(float, __builtin_amdgcn_readlane(__builtin_bit_cast(int, glall), n));
        LAS unsigned char* buf = lds + (n & 1) * 57344;
        if (n + 1 < 64) {
            const unsigned char* opn = ops0 + (size_t)(n + 1) * OPS_BYTES;
            scan_issue(lds + ((n + 1) & 1) * 57344, opn, lane);
            Un[0] = *(const u32x4*)(opn + OPS_U + ((ds * 2 + 0) * 64 + lane) * 16); Un[1] = *(const u32x4*)(opn + OPS_U + ((ds * 2 + 1) * 64 + lane) * 16);
        }
        __builtin_amdgcn_sched_barrier(0);
#define SC_LD(dst, base, idx) dst = *(const LAS bf16x8*)(buf + (base) + ((idx) * 64 + lane) * 16)
#define SC_SB __builtin_amdgcn_sched_barrier(0)
        bf16x8 fa[8], fb[8];
        f32x4 vn[4], o[4];
        vn[0] = (f32x4){bf_lo(U0.x), bf_hi(U0.x), bf_lo(U0.y), bf_hi(U0.y)}; vn[1] = (f32x4){bf_lo(U0.z), bf_hi(U0.z), bf_lo(U0.w), bf_hi(U0.w)};
        vn[2] = (f32x4){bf_lo(U1.x), bf_hi(U1.x), bf_lo(U1.y), bf_hi(U1.y)}; vn[3] = (f32x4){bf_lo(U1.z), bf_hi(U1.z), bf_lo(U1.w), bf_hi(U1.w)};
#pragma unroll
        for (int mt = 0; mt < 4; ++mt) o[mt] = (f32x4){0.f, 0.f, 0.f, 0.f};
#pragma unroll
        for (int mt = 0; mt < 4; ++mt) { SC_LD(fa[mt * 2 + 0], OPS_W, mt * 4 + 0); SC_LD(fa[mt * 2 + 1], OPS_W, mt * 4 + 1); }
        SC_SB;
#pragma unroll
        for (int mt = 0; mt < 4; ++mt) { SC_LD(fb[mt * 2 + 0], OPS_W, mt * 4 + 2); SC_LD(fb[mt * 2 + 1], OPS_W, mt * 4 + 3); }
        SC_SB;
#pragma unroll
        for (int k = 0; k < 2; ++k)
#pragma unroll
            for (int mt = 0; mt < 4; ++mt) vn[mt] = __builtin_amdgcn_mfma_f32_16x16x32_bf16(fa[mt * 2 + k], Sb[k], vn[mt], 0, 0, 0);
        SC_SB;
#pragma unroll
        for (int mt = 0; mt < 4; ++mt) { SC_LD(fa[mt * 2 + 0], OPS_Q, mt * 4 + 0); SC_LD(fa[mt * 2 + 1], OPS_Q, mt * 4 + 1); }
        SC_SB;
#pragma unroll
        for (int k = 0; k < 2; ++k)
#pragma unroll
            for (int mt = 0; mt < 4; ++mt) vn[mt] = __builtin_amdgcn_mfma_f32_16x16x32_bf16(fb[mt * 2 + k], Sb[2 + k], vn[mt], 0, 0, 0);
        bf16x8 vb[2]; vb[0] = pack8(vn[0], vn[1]); vb[1] = pack8(vn[2], vn[3]);
        SC_SB;
#pragma unroll
        for (int mt = 0; mt < 4; ++mt) { SC_LD(fb[mt * 2 + 0], OPS_Q, mt * 4 + 2); SC_LD(fb[mt * 2 + 1], OPS_Q, mt * 4 + 3); }
        SC_SB;
#pragma unroll
        for (int k = 0; k < 2; ++k)
#pragma unroll
            for (int mt = 0; mt < 4; ++mt) o[mt] = __builtin_amdgcn_mfma_f32_16x16x32_bf16(fa[mt * 2 + k], Sb[k], o[mt], 0, 0, 0);
        SC_SB;
#pragma unroll
        for (int i = 0; i < 8; ++i) SC_LD(fa[i], OPS_A, i);
        SC_SB;
#pragma unroll
        for (int k = 0; k < 2; ++k)
#pragma unroll
            for (int mt = 0; mt < 4; ++mt) o[mt] = __builtin_amdgcn_mfma_f32_16x16x32_bf16(fb[mt * 2 + k], Sb[2 + k], o[mt], 0, 0, 0);
        SC_SB;
#pragma unroll
        for (int i = 0; i < 8; ++i) SC_LD(fb[i], OPS_KT, i);
        SC_SB;
#pragma unroll
        for (int k2 = 0; k2 < 2; ++k2)
#pragma unroll
            for (int mt = 0; mt < 4; ++mt) o[mt] = __builtin_amdgcn_mfma_f32_16x16x32_bf16(fa[mt * 2 + k2], vb[k2], o[mt], 0, 0, 0);
        SC_SB;
#pragma unroll
        for (int i = 0; i < 8; ++i) SC_LD(fa[i], OPS_KT, 8 + i);
        SC_SB;
        {
#pragma unroll
            for (int mt = 0; mt < 4; ++mt)
#pragma unroll
                for (int j = 0; j < 4; ++j) OT[(16 * mt + 4 * fq + j) * 20 + fr] = o[mt][j];
            bf16_t* op = O + ((size_t)b * SEQ + n * 64 + (lane >> 2)) * 1024 + h * 128 + ds * 16 + (lane & 3) * 4;
#pragma unroll
            for (int i = 0; i < 4; ++i) { const f32x4 v = *(const LAS f32x4*)(OT + (16 * i + (lane >> 2)) * 20 + (lane & 3) * 4);
                u32x2 w; w.x = cvt_pk_bf16(v[0], v[1]); w.y = cvt_pk_bf16(v[2], v[3]); *(u32x2*)(op + (size_t)(16 * i) * 1024) = w; }
        }
        SC_SB;
#pragma unroll
        for (int dt = 0; dt < 8; ++dt) S[dt] *= egl;
#pragma unroll
        for (int k2 = 0; k2 < 2; ++k2)
#pragma unroll
            for (int dt = 0; dt < 4; ++dt) S[dt] = __builtin_amdgcn_mfma_f32_16x16x32_bf16(fb[dt * 2 + k2], vb[k2], S[dt], 0, 0, 0);
        SC_SB;
#pragma unroll
        for (int k2 = 0; k2 < 2; ++k2)
#pragma unroll
            for (int dt = 0; dt < 4; ++dt) S[4 + dt] = __builtin_amdgcn_mfma_f32_16x16x32_bf16(fa[dt * 2 + k2], vb[k2], S[4 + dt], 0, 0, 0);
        SC_SB;
#undef SC_LD
#undef SC_SB
#pragma unroll
        for (int kb = 0; kb < 4; ++kb) Sb[kb] = pack8(S[2 * kb], S[2 * kb + 1]);
        __builtin_amdgcn_sched_barrier(0);
        asm volatile("s_waitcnt lgkmcnt(0)" ::: "memory");
    }
    asm volatile("s_waitcnt vmcnt(0)" ::: "memory");
}

struct WcItem { const float* src; bf16_t* dst; int N, Kd; };
constexpr int NWL_FFN = 3 * 5632;
constexpr int SC_CONV = 2 * 57344 + 5120;
constexpr int SC_CONV_WAVE = 8704;
__device__ __forceinline__ WcItem wc_item(const Params& P, int i, const float* wg, const float* wu, const float* wd) {
    bf16_t* WUP = (bf16_t*)(P.ws + WS_WUP); bf16_t* WDN = (bf16_t*)(P.ws + WS_WDN);
    WcItem it;
    if (i < 11264) { const int up = i >= 5632; if (up) i -= 5632; const int k0 = (i / 176) * 64, n0 = (i % 176) * 32;
        it.src = (up ? wu : wg) + (size_t)k0 * DFF + n0; it.N = DFF; it.Kd = DM; it.dst = WUP + (size_t)(256 * (n0 >> 7) + (n0 & 127) + (up ? 128 : 0)) * DM + k0; }
    else { i -= 11264; const int k0 = (i / 64) * 64, n0 = (i % 64) * 32; it.src = wd + (size_t)k0 * DM + n0; it.N = DM; it.Kd = DFF; it.dst = WDN + (size_t)n0 * DFF + k0; }
    return it;
}
__device__ __forceinline__ void wc_load(const WcItem& it, f32x4 (&v)[8], int lane) {
    const int r = lane >> 3, c4 = (lane & 7) * 4;
#pragma unroll
    for (int i = 0; i < 8; ++i) v[i] = __builtin_nontemporal_load((const f32x4*)(it.src + (size_t)(8 * i + r) * it.N + c4));
}
__device__ __forceinline__ void wc_store(const WcItem& it, const f32x4 (&v)[8], LAS float* scr, int lane) {
    const int r = lane >> 3, c4 = (lane & 7) * 4;
#pragma unroll
    for (int i = 0; i < 8; ++i) { LAS float* d = scr + (8 * i + r) * 34 + c4; *(LAS f32x2*)d = (f32x2){v[i][0], v[i][1]}; *(LAS f32x2*)(d + 2) = (f32x2){v[i][2], v[i][3]}; }
    asm volatile("s_waitcnt lgkmcnt(0)" ::: "memory");
#pragma unroll
    for (int j = 0; j < 4; ++j) {
        const int o = lane + 64 * j, kg = o & 7, n = o >> 3;
        float f[8];
#pragma unroll
        for (int t = 0; t < 8; ++t) f[t] = scr[(8 * kg + t) * 34 + n];
        u32x4 w; w.x = cvt_pk_bf16(f[0], f[1]); w.y = cvt_pk_bf16(f[2], f[3]); w.z = cvt_pk_bf16(f[4], f[5]); w.w = cvt_pk_bf16(f[6], f[7]);
        *(u32x4*)(it.dst + (size_t)n * it.Kd + 8 * kg) = w;
    }
    asm volatile("s_waitcnt lgkmcnt(0)" ::: "memory");
}
__device__ __forceinline__ void wc_wave_loop(const Params& P, const float* wg, const float* wu, const float* wd, LAS float* scr, int gw, int NW, int lane) {
    int i0 = gw;
    if (i0 >= NWL_FFN) return;
    WcItem A = wc_item(P, i0, wg, wu, wd), B = A; bool hasB = (i0 + NW) < NWL_FFN;
    if (hasB) B = wc_item(P, i0 + NW, wg, wu, wd);
    f32x4 va[8], vb[8];
#pragma unroll
    for (int i = 0; i < 8; ++i) vb[i] = (f32x4){0.f, 0.f, 0.f, 0.f};
    wc_load(A, va, lane); if (hasB) wc_load(B, vb, lane);
    for (;;) {
        const WcItem cA = A, cB = B; const bool cHasB = hasB;
        f32x4 ca[8], cb[8];
#pragma unroll
        for (int i = 0; i < 8; ++i) { ca[i] = va[i]; cb[i] = vb[i]; }
        i0 += 2 * NW;
        const bool more = i0 < NWL_FFN;
        if (more) { A = wc_item(P, i0, wg, wu, wd); hasB = (i0 + NW) < NWL_FFN; if (hasB) B = wc_item(P, i0 + NW, wg, wu, wd);
            wc_load(A, va, lane); if (hasB) wc_load(B, vb, lane); }
        wc_store(cA, ca, scr, lane);
        if (cHasB) wc_store(cB, cb, scr, lane);
        if (!more) break;
    }
}

__device__ __forceinline__ void dn_out_phase(const Params& P) {
    const bf16_t* O = (const bf16_t*)(P.ws + WS_O); const bf16_t* PB = (const bf16_t*)(P.ws + WS_BIG); bf16_t* Y = (bf16_t*)(P.ws + WS_H);
    const int lane = threadIdx.x & 63, wid = threadIdx.x >> 6;
    const int d0 = (lane & 7) * 16;
    float nw[16];
#pragma unroll
    for (int i = 0; i < 16; ++i) nw[i] = P.dn_norm_w[d0 + i];
    const int NW = gridDim.x * 8;
    for (int row0 = blockIdx.x * 8 + wid; row0 < T_TOK; row0 += 2 * NW) {
        f32x4 v[2][4]; u32x4 z[2][2];
#pragma unroll
        for (int r = 0; r < 2; ++r) { const int row = (row0 + r * NW < T_TOK) ? row0 + r * NW : row0;
            const u32x4* op = (const u32x4*)(O + (size_t)row * 1024 + lane * 16);
            const u32x4* zp = (const u32x4*)(PB + (size_t)row * NIN + 5120 + lane * 16);
            const u32x4 q0 = op[0], q1 = op[1];
            v[r][0] = (f32x4){bf_lo(q0.x), bf_hi(q0.x), bf_lo(q0.y), bf_hi(q0.y)}; v[r][1] = (f32x4){bf_lo(q0.z), bf_hi(q0.z), bf_lo(q0.w), bf_hi(q0.w)};
            v[r][2] = (f32x4){bf_lo(q1.x), bf_hi(q1.x), bf_lo(q1.y), bf_hi(q1.y)}; v[r][3] = (f32x4){bf_lo(q1.z), bf_hi(q1.z), bf_lo(q1.w), bf_hi(q1.w)};
            z[r][0] = zp[0]; z[r][1] = zp[1]; }
#pragma unroll
        for (int r = 0; r < 2; ++r) {
            const int row = row0 + r * NW;
            if (row < T_TOK) {
                float ss = 0.f;
#pragma unroll
                for (int i = 0; i < 4; ++i) ss += (v[r][i].x * v[r][i].x + v[r][i].y * v[r][i].y) + (v[r][i].z * v[r][i].z + v[r][i].w * v[r][i].w);
                ss += __shfl_xor(ss, 1); ss += __shfl_xor(ss, 2); ss += __shfl_xor(ss, 4);
                const float rstd = 1.f / sqrtf(ss * (1.f / 128.f) + 1e-6f);
                const unsigned zz[8] = {z[r][0].x, z[r][0].y, z[r][0].z, z[r][0].w, z[r][1].x, z[r][1].y, z[r][1].z, z[r][1].w};
                unsigned w[8];
#pragma unroll
                for (int i = 0; i < 8; ++i) {
                    const float a = v[r][i >> 1][(i & 1) * 2] * rstd * nw[2 * i] * fast_silu(bf_lo(zz[i]));
                    const float bq = v[r][i >> 1][(i & 1) * 2 + 1] * rstd * nw[2 * i + 1] * fast_silu(bf_hi(zz[i]));
                    w[i] = cvt_pk_bf16(a, bq);
                }
                u32x4* yp = (u32x4*)(Y + (size_t)row * DM + 1024 + lane * 16);
                yp[0] = (u32x4){w[0], w[1], w[2], w[3]}; yp[1] = (u32x4){w[4], w[5], w[6], w[7]};
            }
        }
    }
}

__device__ __forceinline__ void final_norm_phase(const Params& P) {
    const bf16_t* X3 = (const bf16_t*)(P.ws + WS_H);
    const int lane = threadIdx.x & 63, wid = threadIdx.x >> 6;
    const int NW = gridDim.x * 8;
    for (int row = blockIdx.x * 8 + wid; row < T_TOK; row += 2 * NW) {
        const int row1 = row + NW; const bool two = row1 < T_TOK;
        const u32x2* xr0 = (const u32x2*)(X3 + (size_t)row * DM) + lane; const u32x2* xr1 = (const u32x2*)(X3 + (size_t)(two ? row1 : row) * DM) + lane;
        u32x2 r0[8], r1[8];
#pragma unroll
        for (int i = 0; i < 8; ++i) { r0[i] = xr0[64 * i]; r1[i] = xr1[64 * i]; }
        f32x4 v0[8], v1[8]; float ss0 = 0.f, ss1 = 0.f;
#pragma unroll
        for (int i = 0; i < 8; ++i) { v0[i] = (f32x4){bf_lo(r0[i].x), bf_hi(r0[i].x), bf_lo(r0[i].y), bf_hi(r0[i].y)}; v1[i] = (f32x4){bf_lo(r1[i].x), bf_hi(r1[i].x), bf_lo(r1[i].y), bf_hi(r1[i].y)};
            ss0 += (v0[i].x * v0[i].x + v0[i].y * v0[i].y) + (v0[i].z * v0[i].z + v0[i].w * v0[i].w);
            ss1 += (v1[i].x * v1[i].x + v1[i].y * v1[i].y) + (v1[i].z * v1[i].z + v1[i].w * v1[i].w); }
#pragma unroll
        for (int o = 1; o < 64; o <<= 1) { const float t0 = __shfl_xor(ss0, o), t1 = __shfl_xor(ss1, o); ss0 += t0; ss1 += t1; }
        const float rstd0 = 1.f / sqrtf(ss0 * (1.f / DM) + 1e-6f), rstd1 = 1.f / sqrtf(ss1 * (1.f / DM) + 1e-6f);
        f32x4* o0 = (f32x4*)(P.out + (size_t)row * DM) + lane; f32x4* o1 = (f32x4*)(P.out + (size_t)(two ? row1 : row) * DM) + lane;
#pragma unroll
        for (int i = 0; i < 8; ++i) { const f32x4 w = *((const f32x4*)P.final_norm + lane + 64 * i); __builtin_nontemporal_store(v0[i] * rstd0 * w, o0 + 64 * i); if (two) __builtin_nontemporal_store(v1[i] * rstd1 * w, o1 + 64 * i); }
    }
}

#define XB_TMO      128
#define XB_XCNT(j)  (256  + 64 * (j))
#define XB_XSUB(j)  (1280 + 64 * (j))
#define XB_XGEN(j)  (2304 + 64 * (j))
#define XB_TOP      3328
#define XB_TOPGEN   3392
#define XCD_BAR_WORDS 3456
#define XB_SPIN_CAP (1u << 22)
__device__ __forceinline__ unsigned xb_ld(unsigned* p)              { return __hip_atomic_load(p, __ATOMIC_RELAXED, __HIP_MEMORY_SCOPE_AGENT); }
__device__ __forceinline__ unsigned xb_add(unsigned* p, unsigned v) { return __hip_atomic_fetch_add(p, v, __ATOMIC_RELAXED, __HIP_MEMORY_SCOPE_AGENT); }
__device__ __forceinline__ unsigned xb_xcc_id() { return (unsigned)__builtin_amdgcn_s_getreg((3 << 11) | 20) & 0xFu; }
#define XB_SPIN(cond, bar) do { unsigned _sp = 0; while (cond) { __builtin_amdgcn_s_sleep(1); \
    if ((++_sp & 255u) == 0u) { if (xb_ld(&(bar)[XB_TMO])) break; if (_sp > XB_SPIN_CAP) { atomicAdd(&(bar)[XB_TMO], 1u); break; } } } } while (0)
struct XcdBarrier { unsigned* bar; unsigned x; volatile LAS unsigned* st; };
__device__ __forceinline__ XcdBarrier xcd_barrier_post(unsigned* bar, volatile LAS unsigned* st) {
    XcdBarrier b; b.bar = bar; b.x = xb_xcc_id(); b.st = st;
    if (threadIdx.x == 0) (void)xb_add(&bar[XB_XCNT(b.x)], 1u);
    return b;
}
__device__ __forceinline__ void xcd_barrier_complete(unsigned* bar, unsigned x, unsigned& nloc, unsigned& nx) {
    const unsigned G = gridDim.x * gridDim.y * gridDim.z;
    unsigned sum, cnt, mine, sp = 0u;
    for (;;) {
        sum = 0u; cnt = 0u; mine = 0u;
#pragma unroll
        for (unsigned j = 0; j < 16; ++j) { const unsigned c = xb_ld(&bar[XB_XCNT(j)]); sum += c; cnt += (c > 0u) ? 1u : 0u; mine = (j == x) ? c : mine; }
        if (sum == G) break;
        __builtin_amdgcn_s_sleep(1);
        if ((++sp & 255u) == 0u) { if (xb_ld(&bar[XB_TMO])) break; if (sp > XB_SPIN_CAP) { atomicAdd(&bar[XB_TMO], 1u); break; } }
    }
    nloc = mine > 0u ? mine : 1u; nx = cnt > 0u ? cnt : 1u;
}
__device__ __forceinline__ void xcd_barrier(const XcdBarrier& b) {
    asm volatile("s_waitcnt vmcnt(0)" ::: "memory");
    __syncthreads();
    if (threadIdx.x == 0) {
        unsigned* bar = b.bar;
        __builtin_amdgcn_s_waitcnt(0);
        unsigned nloc = b.st[0], nx = b.st[1];
        if (nloc == 0u) { xcd_barrier_complete(bar, b.x, nloc, nx); b.st[0] = nloc; b.st[1] = nx; }
        const unsigned old = xb_add(&bar[XB_XSUB(b.x)], 1u);
        const unsigned gen = old / nloc;
        if (old + 1u == (gen + 1u) * nloc) {
            __builtin_amdgcn_fence(__ATOMIC_RELEASE, "agent");
            asm volatile("s_waitcnt vmcnt(0)" ::: "memory");
            const unsigned og = xb_add(&bar[XB_TOP], 1u);
            const unsigned tg = og / nx;
            if (og + 1u == (tg + 1u) * nx) xb_add(&bar[XB_TOPGEN], 1u);
            else XB_SPIN(xb_ld(&bar[XB_TOPGEN]) == tg, bar);
            __builtin_amdgcn_fence(__ATOMIC_ACQUIRE, "agent");
            xb_add(&bar[XB_XGEN(b.x)], 1u);
            asm volatile("s_waitcnt vmcnt(0)" ::: "memory");
        } else {
            XB_SPIN(xb_ld(&bar[XB_XGEN(b.x)]) == gen, bar);
            __builtin_amdgcn_fence(__ATOMIC_ACQUIRE, "agent");
            asm volatile("s_waitcnt vmcnt(0)" ::: "memory");
        }
    }
    __syncthreads();
}

constexpr int N_PHASES = 14;
#ifdef ONLY_PH
#define PH_ON(k) ((k) == ONLY_PH)
#else
#define PH_ON(k) 1
#endif
__global__ void __launch_bounds__(512, 2) fwd_megakernel(Params P) {
    extern __shared__ __attribute__((aligned(16))) unsigned char lds_raw[];
    LAS unsigned char* lds = (LAS unsigned char*)lds_raw;
    const int G = gridDim.x;
    bf16_t* H = (bf16_t*)(P.ws + WS_H); bf16_t* BIG = (bf16_t*)(P.ws + WS_BIG);
    bf16_t* XB = (bf16_t*)P.out;
    const bf16_t* WUP = (const bf16_t*)(P.ws + WS_WUP); const bf16_t* WDN = (const bf16_t*)(P.ws + WS_WDN);
    const bf16_t* WIN = (const bf16_t*)(P.ws + WS_WIN); const bf16_t* WOUT = (const bf16_t*)(P.ws + WS_WOUT);
    const float* mods = (const float*)(P.ws + WS_MODS);
    const int lo = P.ph_lo, hi = P.ph_hi;
    volatile LAS unsigned* xst = (volatile LAS unsigned*)(lds + LDS_BYTES - 16);
    XcdBarrier xbar; xbar.bar = (unsigned*)(P.ws + WS_BAR); xbar.x = 0; xbar.st = xst;
    if (hi - lo > 1) {
        if (threadIdx.x == 0) { xst[0] = 0u; xst[1] = 0u; }
        __syncthreads();
        xbar = xcd_barrier_post((unsigned*)(P.ws + WS_BAR), xst);
    }
    if (lo < 0) cg::this_grid().sync();
#define IN(k) (PH_ON(k) && lo <= (k) && (k) < hi)
#define SEAM(k) do { if (lo <= (k) && (k) + 1 < hi) { for (int _s = 0; _s < PROBE_SYNC_REP; ++_s) { xcd_barrier(xbar); } } } while (0)
#define REPN(k) for (int _r = 0; _r < (((PROBE_REP_MASK >> (k)) & 1) ? 2 : 1); ++_r)
    if (IN(0)) REPN(0) { phase0(P, lds); }
    SEAM(0);
    if (IN(1)) REPN(1) { mods_finalize(P); norm_mod_phase<false>(P, lds, P.x, P.ffn1_norm, 0, true, H); }
    SEAM(1);
    if (IN(2)) REPN(2) { pg8::Gemm g{H, WUP, T_TOK, NUP, DM}; pg8::StaticOrder S; S.init(T_TOK, NUP, G, blockIdx.x, 8); pg8::EpiSwiGLU E{BIG, DFF}; pg8::gemm_phase(lds, g, S, E); }
    SEAM(2);
    if (IN(3)) REPN(3) { pg8::Gemm g{BIG, WDN, T_TOK, DM, DFF}; pg8::StaticOrder S; S.init(T_TOK, DM, G, blockIdx.x); pg8::EpiResidB<false, true> E{P.x, XB, mods + 2 * DM}; pg8::gemm_phase(lds, g, S, E); }
    SEAM(3);
    if (IN(4)) REPN(4) { norm_mod_phase<true>(P, lds, XB, P.mix_norm, 3, false, H); }
    SEAM(4);
    if (IN(5)) REPN(5) { pg8::Gemm g{H, WIN, T_TOK, 6144, DM}; pg8::StaticOrder S; S.init(T_TOK, 6144, G, blockIdx.x); pg8::EpiBf16 E{BIG, NIN}; pg8::gemm_phase(lds, g, S, E); gate_cols_phase(P, lds); }
    SEAM(5);
    if (IN(6)) REPN(6) {
        for (int _p = 0; _p < PROBE_PREP_REP; ++_p) { float gb = 0.f, ga = 0.f; int ch = blockIdx.x;
            if (ch < NCH_TOT) dn_gate_load(P, ch, gb, ga);
            for (; ch < NCH_TOT; ch += G) dn_prep_chunk(P, lds, ch, gb, ga, (ch + G < NCH_TOT) ? ch + G : -1); }
        for (int _p = 0; _p < PROBE_CONV_REP; ++_p) for (int it = blockIdx.x; it < NB * (SEQ / 32); it += G) conv_item(P, lds, it);
    }
    SEAM(6);
    if (IN(7)) REPN(7) {
        const int wv = threadIdx.x >> 6;
        if (wv == 0) { for (int chain = blockIdx.x; chain < 256; chain += G) scan_chain(P, lds, chain); }
        else if (wv >= 3) {
            const int lane = threadIdx.x & 63, gw = blockIdx.x * 5 + (wv - 3), NW = G * 5;
            LAS float* scr = (LAS float*)(lds + SC_CONV + (wv - 3) * SC_CONV_WAVE);
            wc_wave_loop(P, P.ffn2_wg, P.ffn2_wu, P.ffn2_wd, scr, gw, NW, lane);
        }
    }
    SEAM(7);
    if (IN(8)) REPN(8) { dn_out_phase(P); }
    SEAM(8);
    if (IN(9)) { pg8::Gemm g{H, WOUT, T_TOK, DM, DM}; pg8::StaticOrder S; S.init(T_TOK, DM, G, blockIdx.x); pg8::EpiResidB<true, false> E{XB, XB, mods + 5 * DM}; pg8::gemm_phase(lds, g, S, E); }
    SEAM(9);
    if (IN(10)) REPN(10) { norm_mod_phase<true>(P, lds, XB, P.ffn2_norm, 6, false, H); }
    SEAM(10);
    if (IN(11)) REPN(11) { pg8::Gemm g{H, WUP, T_TOK, NUP, DM}; pg8::StaticOrder S; S.init(T_TOK, NUP, G, blockIdx.x, 8); pg8::EpiSwiGLU E{BIG, DFF}; pg8::gemm_phase(lds, g, S, E); }
    SEAM(11);
    if (IN(12)) { pg8::Gemm g{BIG, WDN, T_TOK, DM, DFF}; pg8::StaticOrder S; S.init(T_TOK, DM, G, blockIdx.x); pg8::EpiResidB<true, true> E{XB, H, mods + 8 * DM}; pg8::gemm_phase(lds, g, S, E); }
    SEAM(12);
    if (IN(13)) { final_norm_phase(P); }
#undef IN
#undef SEAM
}

extern "C" void kernel_launch(void* const* d_in, const int* in_sizes, int n_in, void* d_out, int out_size, void* d_ws, size_t ws_size, hipStream_t stream) {
    static int grid = 0;
    if (grid == 0) {
        if (n_in != 24 || out_size != T_TOK * DM || ws_size < WS_END) { fprintf(stderr, "kernel_launch: unexpected shapes (n_in %d out %d ws %zu need %zu)\n", n_in, out_size, ws_size, (size_t)WS_END); grid = -1; return; }
        int dev = 0, cus = 0, per_cu = 0;
        hipGetDevice(&dev); hipDeviceGetAttribute(&cus, hipDeviceAttributeMultiprocessorCount, dev);
        if (hipFuncSetAttribute((const void*)fwd_megakernel, hipFuncAttributeMaxDynamicSharedMemorySize, LDS_BYTES) != hipSuccess) { fprintf(stderr, "kernel_launch: hipFuncSetAttribute failed\n"); grid = -1; return; }
        hipOccupancyMaxActiveBlocksPerMultiprocessor(&per_cu, (const void*)fwd_megakernel, 512, LDS_BYTES);
        if (per_cu < 1) { fprintf(stderr, "kernel_launch: occupancy query says %d\n", per_cu); per_cu = 1; }
        (void)hipGetLastError();
        grid = cus;
    }
    if (grid < 0) return;
    Params p{};
    const float** pp = (const float**)&p;
    for (int i = 0; i < 24; ++i) pp[i] = (const float*)d_in[i];
    p.out = (float*)d_out; p.ws = (unsigned char*)d_ws;
    hipMemsetAsync(d_ws, 0, XCD_BAR_WORDS * 4, stream);
#if MK_MULTI
    for (int ph = 0; ph < N_PHASES; ++ph) { p.ph_lo = ph; p.ph_hi = ph + 1; hipLaunchKernelGGL(fwd_megakernel, dim3(grid), dim3(512), LDS_BYTES, stream, p); }
#else
    p.ph_lo = 0; p.ph_hi = N_PHASES;
    void* args[] = {&p};
    hipError_t e = hipLaunchCooperativeKernel((const void*)fwd_megakernel, dim3(grid), dim3(512), args, LDS_BYTES, stream);
    if (e != hipSuccess) fprintf(stderr, "cooperative launch failed: %s (grid %d)\n", hipGetErrorString(e), grid);
#endif
}
```

```cpp
#include <hip/hip_runtime.h>
#include <hip/hip_cooperative_groups.h>
#include <cstdio>
namespace cg = cooperative_groups;

#ifndef MK_MULTI
#define MK_MULTI 0
#endif

#ifndef PROBE_REP_MASK
#define PROBE_REP_MASK 0
#endif
#ifndef PROBE_PREP_REP
#define PROBE_PREP_REP 1
#endif
#ifndef PROBE_CONV_REP
#define PROBE_CONV_REP 1
#endif
#ifndef PROBE_SYNC_REP
#define PROBE_SYNC_REP 1
#endif
#define LAS __attribute__((address_space(3)))
typedef unsigned short bf16_t;
typedef short bf16x8 __attribute__((ext_vector_type(8)));
typedef float f32x4 __attribute__((ext_vector_type(4)));
typedef float f32x2 __attribute__((ext_vector_type(2)));
typedef unsigned u32x4 __attribute__((ext_vector_type(4)));
typedef unsigned u32x2 __attribute__((ext_vector_type(2)));

constexpr int T_TOK = 16384, DM = 2048, DFF = 5632, NUP = 2 * DFF, SEQ = 4096, NB = 4;
constexpr int NIN_REAL = 6160, NIN = 6400, NMOD = 9 * DM;
constexpr int KS_ADA = 8;
constexpr int NCHUNK = 64, NHEAD = 8, NCH_TOT = NB * NHEAD * NCHUNK;
constexpr int OPS_BYTES = 73728;
constexpr int OPS_W = 0, OPS_Q = 16384, OPS_KT = 32768, OPS_A = 49152, OPS_U = 57344;
constexpr int LDS_BYTES = 163840;

constexpr size_t al256(size_t x) { return (x + 255) & ~(size_t)255; }
constexpr size_t WS_BAR = 0;
constexpr size_t WS_MODP = 16384;
constexpr size_t WS_MODS = al256(WS_MODP + (size_t)KS_ADA * NB * NMOD * 4);
constexpr size_t WS_GL   = al256(WS_MODS + (size_t)NB * NMOD * 4);
constexpr size_t WS_WUP  = al256(WS_GL + (size_t)NCH_TOT * 4);
constexpr size_t WS_WDN  = al256(WS_WUP + (size_t)NUP * DM * 2);
constexpr size_t WS_WIN  = al256(WS_WDN + (size_t)DM * DFF * 2);
constexpr size_t WS_WOUT = al256(WS_WIN + (size_t)NIN * DM * 2);
constexpr size_t WS_H    = al256(WS_WOUT + (size_t)DM * DM * 2);
constexpr size_t WS_BIG  = al256(WS_H + (size_t)T_TOK * DM * 2);
constexpr size_t WS_SCAN = al256(WS_BIG + (size_t)T_TOK * NIN * 2);
constexpr size_t WS_O    = al256(WS_SCAN + (size_t)NCH_TOT * OPS_BYTES);
constexpr size_t WS_END  = al256(WS_O + (size_t)T_TOK * 1024 * 4);

struct Params {
    const float *x, *c, *w_ada, *b_ada, *ffn1_norm, *ffn1_wg, *ffn1_wu, *ffn1_wd, *mix_norm, *w_in, *w_dw, *b_dw, *conv_ln_w, *conv_ln_b,
                *w_short, *a_log, *dt_bias, *dn_norm_w, *w_out, *ffn2_norm, *ffn2_wg, *ffn2_wu, *ffn2_wd, *final_norm;
    float* out; unsigned char* ws;
    int ph_lo, ph_hi;
};

typedef __bf16 bf16x2_t __attribute__((ext_vector_type(2)));
__device__ __forceinline__ unsigned cvt_pk_bf16(float lo, float hi) { const f32x2 v = {lo, hi}; const bf16x2_t r = __builtin_convertvector(v, bf16x2_t); return __builtin_bit_cast(unsigned, r); }
__device__ __forceinline__ float bf_lo(unsigned w) { return __uint_as_float(w << 16); }
__device__ __forceinline__ float bf_hi(unsigned w) { return __uint_as_float(w & 0xffff0000u); }
__device__ __forceinline__ float bf1(bf16_t v) { return __uint_as_float(((unsigned)v) << 16); }
__device__ __forceinline__ float wave_sum(float v) {
#pragma unroll
    for (int o = 1; o < 64; o <<= 1) v += __shfl_xor(v, o);
    return v;
}
#define LDS_BARRIER() do { asm volatile("s_waitcnt lgkmcnt(0)" ::: "memory"); __builtin_amdgcn_s_barrier(); asm volatile("" ::: "memory"); } while (0)
__device__ __forceinline__ float fast_sigmoid(float v) { return __builtin_amdgcn_rcpf(1.f + __builtin_amdgcn_exp2f(-1.44269504f * v)); }
__device__ __forceinline__ float fast_silu(float v) { return v * fast_sigmoid(v); }

namespace pg8 {
constexpr int BM = 256, BK = 64, HALF = 128, HTB = HALF * BK * 2, STAGE_BYTES = 8 * HTB, NXCD = 8, WGM = 4;
__host__ __device__ __forceinline__ int lds_byte(int r, int c) { const int st = (r >> 4) * 2 + (c >> 5), rr = r & 15, cc = c & 31, ob = rr * 64 + cc * 2; return st * 1024 + (ob ^ (((ob >> 9) & 1) << 5)); }
__host__ __device__ __forceinline__ void stage_rc(int b, int& R, int& C) { const int st = b / 1024, sb = b % 1024, swz = sb ^ (((sb >> 9) & 1) << 5); R = (st >> 1) * 16 + swz / 64; C = (st & 1) * 32 + (swz % 64) / 2; }
__host__ __device__ __forceinline__ int perm32(int rho) { const int n = rho >> 4, i = rho & 15; return 8 * (i >> 2) + 4 * n + (i & 3); }
struct Unit { int pm, pn; };
struct Gemm { const bf16_t* A; const bf16_t* Bt; int M, N, K; };
struct StaticOrder {
    int nM, nN, nwg, G, c, wgm;
    __host__ __device__ void init(int M, int N, int G_, int c_, int wgm_ = WGM) { nM = M / BM; nN = N / BM; nwg = nM * nN; G = G_; c = c_; wgm = wgm_; }
    __host__ __device__ bool next(int i, Unit& u) const {
        const long L = (long)i * G + c; if (L >= nwg) return false;
        int wgid = (int)L; { const int q = nwg / NXCD, r = nwg % NXCD, xcd = wgid % NXCD, off = wgid / NXCD; wgid = (xcd < r ? xcd * (q + 1) : r * (q + 1) + (xcd - r) * q) + off; }
        const int nig = wgm * nN, gid = wgid / nig, fm = gid * wgm, gsz = (nM - fm) < wgm ? (nM - fm) : wgm;
        u.pm = fm + ((wgid % nig) % gsz); u.pn = (wgid % nig) / gsz; return true;
    }
};

struct EpiSwiGLU {
    static constexpr bool PERM = true;
    bf16_t* O; int ldc;
    __device__ __forceinline__ void operator()(const f32x4 (&acc)[2][2][4][2], const Unit& u, int wr, int wc, int fr, int fq) const {
        const int row0 = u.pm * BM + wr * 64 + fr, col0 = u.pn * HALF + wc * 32 + 8 * fq;
#pragma unroll
        for (int ai = 0; ai < 2; ++ai)
#pragma unroll
            for (int m = 0; m < 4; ++m) {
                bf16_t* rowp = O + (size_t)(row0 + ai * HALF + m * 16) * ldc + col0;
                float v[8];
#pragma unroll
                for (int n = 0; n < 2; ++n)
#pragma unroll
                    for (int j = 0; j < 4; ++j) { const float g = acc[ai][0][m][n][j], uu = acc[ai][1][m][n][j]; v[n * 4 + j] = fast_silu(g) * uu; }
                u32x4 w; w.x = cvt_pk_bf16(v[0], v[1]); w.y = cvt_pk_bf16(v[2], v[3]); w.z = cvt_pk_bf16(v[4], v[5]); w.w = cvt_pk_bf16(v[6], v[7]);
                *(u32x4*)rowp = w;
            }
    }
};
struct EpiResid {
    static constexpr bool PERM = false;
    const float* base; float* out; const float* gate; float gs;
    __device__ __forceinline__ void operator()(const f32x4 (&acc)[2][2][4][2], const Unit& u, int wr, int wc, int fr, int fq) const {
        const int row0 = u.pm * BM + wr * 64 + fr, col0 = u.pn * BM + wc * 32 + 4 * fq, b = u.pm >> 4;
        f32x4 gv[2][2];
#pragma unroll
        for (int bj = 0; bj < 2; ++bj)
#pragma unroll
            for (int n = 0; n < 2; ++n) gv[bj][n] = *(const f32x4*)(gate + (size_t)b * NMOD + col0 + bj * HALF + n * 16) * gs;
#pragma unroll
        for (int ai = 0; ai < 2; ++ai)
#pragma unroll
            for (int m = 0; m < 4; ++m) {
                const size_t off = (size_t)(row0 + ai * HALF + m * 16) * DM + col0;
#pragma unroll
                for (int bj = 0; bj < 2; ++bj)
#pragma unroll
                    for (int n = 0; n < 2; ++n) { const f32x4 bb = *(const f32x4*)(base + off + bj * HALF + n * 16); *(f32x4*)(out + off + bj * HALF + n * 16) = bb + gv[bj][n] * acc[ai][bj][m][n]; }
            }
    }
};
template <bool BASE_BF16, bool HALFG> struct EpiResidB {
    static constexpr bool PERM = false;
    const void* base; bf16_t* out; const float* gate;
    static constexpr float gs = HALFG ? 0.5f : 1.0f;
    __device__ __forceinline__ void operator()(const f32x4 (&acc)[2][2][4][2], const Unit& u, int wr, int wc, int fr, int fq) const {
        const int row0 = u.pm * BM + wr * 64 + fr, col0 = u.pn * BM + wc * 32 + 4 * fq, b = u.pm >> 4;
        f32x4 gv[2][2];
#pragma unroll
        for (int bj = 0; bj < 2; ++bj)
#pragma unroll
            for (int n = 0; n < 2; ++n) gv[bj][n] = *(const f32x4*)(gate + (size_t)b * NMOD + col0 + bj * HALF + n * 16) * gs;
#pragma unroll
        for (int ai = 0; ai < 2; ++ai) {
            f32x4 bb[4][2][2];
#pragma unroll
            for (int m = 0; m < 4; ++m) {
                const size_t off = (size_t)(row0 + ai * HALF + m * 16) * DM + col0;
#pragma unroll
                for (int bj = 0; bj < 2; ++bj)
#pragma unroll
                    for (int n = 0; n < 2; ++n) {
                        if (BASE_BF16) { const u32x2 r = *(const u32x2*)((const bf16_t*)base + off + bj * HALF + n * 16); bb[m][bj][n] = (f32x4){__uint_as_float(r.x), __uint_as_float(r.y), 0.f, 0.f}; }
                        else bb[m][bj][n] = *(const f32x4*)((const float*)base + off + bj * HALF + n * 16);
                    }
            }
            __builtin_amdgcn_sched_barrier(0);
#pragma unroll
            for (int m = 0; m < 4; ++m) {
                const size_t off = (size_t)(row0 + ai * HALF + m * 16) * DM + col0;
#pragma unroll
                for (int bj = 0; bj < 2; ++bj)
#pragma unroll
                    for (int n = 0; n < 2; ++n) {
                        f32x4 x;
                        if (BASE_BF16) { const unsigned r0 = __float_as_uint(bb[m][bj][n][0]), r1 = __float_as_uint(bb[m][bj][n][1]); x = (f32x4){bf_lo(r0), bf_hi(r0), bf_lo(r1), bf_hi(r1)}; }
                        else x = bb[m][bj][n];
                        const f32x4 xn = x + gv[bj][n] * acc[ai][bj][m][n];
                        u32x2 w; w.x = cvt_pk_bf16(xn[0], xn[1]); w.y = cvt_pk_bf16(xn[2], xn[3]);
                        *(u32x2*)(out + off + bj * HALF + n * 16) = w;
                    }
            }
            __builtin_amdgcn_sched_barrier(0);
        }
    }
};
struct EpiBf16 {
    static constexpr bool PERM = true;
    bf16_t* O; int ldc;
    __device__ __forceinline__ void operator()(const f32x4 (&acc)[2][2][4][2], const Unit& u, int wr, int wc, int fr, int fq) const {
        const int row0 = u.pm * BM + wr * 64 + fr, col0 = u.pn * BM + wc * 32 + 8 * fq;
#pragma unroll
        for (int ai = 0; ai < 2; ++ai)
#pragma unroll
            for (int m = 0; m < 4; ++m) {
                bf16_t* rowp = O + (size_t)(row0 + ai * HALF + m * 16) * ldc + col0;
#pragma unroll
                for (int bj = 0; bj < 2; ++bj) { const f32x4 v0 = acc[ai][bj][m][0], v1 = acc[ai][bj][m][1];
                    u32x4 w; w.x = cvt_pk_bf16(v0[0], v0[1]); w.y = cvt_pk_bf16(v0[2], v0[3]); w.z = cvt_pk_bf16(v1[0], v1[1]); w.w = cvt_pk_bf16(v1[2], v1[3]);
                    *(u32x4*)(rowp + bj * HALF) = w; }
            }
    }
};

template <class Epi>
__device__ __forceinline__ void gemm_phase(LAS unsigned char* lds, const Gemm g, const StaticOrder& S, const Epi& E) {
    const int tid = threadIdx.x, wid = __builtin_amdgcn_readfirstlane(tid >> 6), lane = tid & 63, wr = wid >> 2, wc = wid & 3, fr = lane & 15, fq = lane >> 4;
    const int K = g.K, nt = K / BK;
    unsigned voffA[2], voffB[2];
#pragma unroll
    for (int i = 0; i < 2; ++i) { int R, C; stage_rc(tid * 16 + i * 8192, R, C); const int Rb = Epi::PERM ? ((R & ~31) + perm32(R & 31)) : R;
        voffA[i] = (unsigned)(R * K + C) * 2u; voffB[i] = (unsigned)(Rb * K + C) * 2u; }
    const size_t kstep = (size_t)(BK * 2);
    const size_t hstep = (size_t)HALF * K * 2;
    const size_t tstep = 2 * hstep;
    const unsigned ldsw = (unsigned)wid * 1024u;
    const int aoff = lds_byte(wr * 64 + fr, fq * 8), boff = lds_byte(wc * 32 + fr, fq * 8);
#define PG8_SA(b, h) (((b) * 2 + (h)) * HTB)
#define PG8_SB(b, h) ((4 + (b) * 2 + (h)) * HTB)
#define PG8_STAGE(bufoff, gbase, voff) do { _Pragma("unroll") for (int _i = 0; _i < 2; ++_i) \
        __builtin_amdgcn_global_load_lds((const unsigned*)((const char*)(gbase) + (voff)[_i]), (LAS unsigned*)(lds + (bufoff) + ldsw + _i * 8192), 16, 0, 0); } while (0)
#define PG8_LDA(dst, b, h) do { _Pragma("unroll") for (int m = 0; m < 4; ++m) _Pragma("unroll") for (int k = 0; k < 2; ++k) dst[m][k] = *(const LAS bf16x8*)(lds + PG8_SA(b, h) + aoff + m * 2048 + k * 1024); } while (0)
#define PG8_LDB(dst, b, h) do { _Pragma("unroll") for (int n = 0; n < 2; ++n) _Pragma("unroll") for (int k = 0; k < 2; ++k) dst[n][k] = *(const LAS bf16x8*)(lds + PG8_SB(b, h) + boff + n * 2048 + k * 1024); } while (0)
#define PG8_MMA(ai, bj, At, Bt) do { __builtin_amdgcn_s_setprio(1); _Pragma("unroll") for (int m = 0; m < 4; ++m) _Pragma("unroll") for (int n = 0; n < 2; ++n) _Pragma("unroll") for (int k = 0; k < 2; ++k) \
        acc[ai][bj][m][n] = __builtin_amdgcn_mfma_f32_16x16x32_bf16(Bt[n][k], At[m][k], acc[ai][bj][m][n], 0, 0, 0); __builtin_amdgcn_s_setprio(0); } while (0)
#define PG8_WAIT_V(n) asm volatile("s_waitcnt vmcnt(" #n ")" ::: "memory")
#define PG8_WAIT_L(n) asm volatile("s_waitcnt lgkmcnt(" #n ")" ::: "memory")
#define PG8_BAR __builtin_amdgcn_s_barrier()
#define PG8_SCHED __builtin_amdgcn_sched_barrier(0)
    Unit cur, nxt; int ui = 0;
    if (!S.next(0, cur)) return;
    f32x4 acc[2][2][4][2];
#pragma unroll
    for (int a = 0; a < 2; ++a)
#pragma unroll
        for (int b = 0; b < 2; ++b)
#pragma unroll
            for (int m = 0; m < 4; ++m)
#pragma unroll
                for (int n = 0; n < 2; ++n) acc[a][b][m][n] = (f32x4){0.f, 0.f, 0.f, 0.f};
    bf16x8 At[4][2], B0[2][2], B1[2][2];
    const char* cA = (const char*)g.A + (size_t)cur.pm * tstep; const char* cB = (const char*)g.Bt + (size_t)cur.pn * tstep;
    PG8_STAGE(PG8_SB(0, 0), cB, voffB); PG8_STAGE(PG8_SA(0, 0), cA, voffA); PG8_STAGE(PG8_SB(0, 1), cB + hstep, voffB); PG8_STAGE(PG8_SA(0, 1), cA + hstep, voffA);
    if (wr == 1) PG8_BAR;
    PG8_WAIT_V(4); PG8_BAR;
    PG8_STAGE(PG8_SB(1, 0), cB + kstep, voffB); PG8_STAGE(PG8_SA(1, 0), cA + kstep, voffA); PG8_STAGE(PG8_SB(1, 1), cB + hstep + kstep, voffB);
    PG8_WAIT_V(6); PG8_BAR;
    for (;;) {
        const bool has_next = S.next(ui + 1, nxt);
        const char* nA = has_next ? (const char*)g.A + (size_t)nxt.pm * tstep : cA; const char* nB = has_next ? (const char*)g.Bt + (size_t)nxt.pn * tstep : cB;
        for (int t = 0; t < nt; t += 2) {
            const bool last = (t == nt - 2);
            const char* a1 = cA + (size_t)(t + 1) * kstep;
            const char* a2 = last ? nA : cA + (size_t)(t + 2) * kstep; const char* b2 = last ? nB : cB + (size_t)(t + 2) * kstep;
            const char* a3 = a2 + kstep; const char* b3 = b2 + kstep;
            PG8_LDB(B0, 0, 0); PG8_SCHED; PG8_LDA(At, 0, 0); PG8_STAGE(PG8_SA(1, 1), a1 + hstep, voffA);
            PG8_WAIT_L(8); PG8_BAR; PG8_WAIT_L(0); PG8_MMA(0, 0, At, B0); PG8_BAR; PG8_SCHED;
            PG8_LDB(B1, 0, 1); PG8_STAGE(PG8_SB(0, 0), b2, voffB);
            PG8_BAR; PG8_WAIT_L(0); PG8_MMA(0, 1, At, B1); PG8_BAR;
            PG8_LDA(At, 0, 1); PG8_STAGE(PG8_SA(0, 0), a2, voffA);
            PG8_BAR; PG8_WAIT_L(0); PG8_MMA(1, 0, At, B0); PG8_BAR; PG8_SCHED;
            PG8_STAGE(PG8_SB(0, 1), b2 + hstep, voffB);
            PG8_WAIT_V(6); PG8_BAR; PG8_MMA(1, 1, At, B1); PG8_BAR;
            PG8_LDB(B0, 1, 0); PG8_SCHED; PG8_LDA(At, 1, 0); PG8_STAGE(PG8_SA(0, 1), a2 + hstep, voffA);
            PG8_WAIT_L(8); PG8_BAR; PG8_WAIT_L(0); PG8_MMA(0, 0, At, B0); PG8_BAR; PG8_SCHED;
            PG8_LDB(B1, 1, 1); PG8_STAGE(PG8_SB(1, 0), b3, voffB);
            PG8_BAR; PG8_WAIT_L(0); PG8_MMA(0, 1, At, B1); PG8_BAR;
            PG8_LDA(At, 1, 1); PG8_STAGE(PG8_SA(1, 0), a3, voffA);
            PG8_BAR; PG8_WAIT_L(0); PG8_MMA(1, 0, At, B0); PG8_BAR; PG8_SCHED;
            PG8_STAGE(PG8_SB(1, 1), b3 + hstep, voffB);
            PG8_WAIT_V(6); PG8_BAR; PG8_MMA(1, 1, At, B1); PG8_BAR;
        }
        E(acc, cur, wr, wc, fr, fq);
        if (!has_next) break;
#pragma unroll
        for (int a = 0; a < 2; ++a)
#pragma unroll
            for (int b = 0; b < 2; ++b)
#pragma unroll
                for (int m = 0; m < 4; ++m)
#pragma unroll
                    for (int n = 0; n < 2; ++n) acc[a][b][m][n] = (f32x4){0.f, 0.f, 0.f, 0.f};
        cur = nxt; cA = nA; cB = nB; ++ui;
    }
    PG8_WAIT_V(0);
    if (wr == 0) PG8_BAR;
    PG8_BAR;
#undef PG8_SA
#undef PG8_SB
#undef PG8_STAGE
#undef PG8_LDA
#undef PG8_LDB
#undef PG8_MMA
#undef PG8_WAIT_V
#undef PG8_WAIT_L
#undef PG8_BAR
#undef PG8_SCHED
}
}

__device__ __forceinline__ void gemv_item(const Params& P, LAS unsigned char* lds, int item) {
    const int cgp = item % 72, ks = item / 72;
    const int tid = threadIdx.x, lane = tid & 63, wid = tid >> 6;
    LAS float* sc = (LAS float*)lds;
    LAS float* red = (LAS float*)(lds + 4096);
    for (int i = tid; i < 1024; i += 512) { const int b = i >> 8, kk = i & 255; const float v = P.c[b * DM + ks * 256 + kk]; sc[i] = v / (1.f + __expf(-v)); }
    LDS_BARRIER();
    float acc[4][4];
#pragma unroll
    for (int b = 0; b < 4; ++b)
#pragma unroll
        for (int e = 0; e < 4; ++e) acc[b][e] = 0.f;
    const float* wp = P.w_ada + (size_t)(ks * 256 + wid * 32) * NMOD + cgp * 256 + lane * 4;
    {
        f32x4 wv[32];
#pragma unroll
        for (int r = 0; r < 32; ++r) wv[r] = __builtin_nontemporal_load((const f32x4*)(wp + (size_t)r * NMOD));
        __builtin_amdgcn_sched_barrier(0);
#pragma unroll
        for (int r = 0; r < 32; ++r) {
            const int kk = wid * 32 + r;
#pragma unroll
            for (int b = 0; b < 4; ++b) { const float s = sc[b * 256 + kk];
#pragma unroll
                for (int e = 0; e < 4; ++e) acc[b][e] += s * wv[r][e]; }
        }
    }
#pragma unroll
    for (int b = 0; b < 4; ++b)
#pragma unroll
        for (int e = 0; e < 4; ++e) red[(wid * 16 + b * 4 + e) * 64 + lane] = acc[b][e];
    LDS_BARRIER();
    float* modp = (float*)(P.ws + WS_MODP);
    for (int o = tid; o < 1024; o += 512) { const int be = o >> 6, ln = o & 63; float s = 0.f;
#pragma unroll
        for (int w = 0; w < 8; ++w) s += red[(w * 16 + be) * 64 + ln];
        const int b = be >> 2, e = be & 3; modp[((size_t)ks * NB + b) * NMOD + cgp * 256 + ln * 4 + e] = s; }
    LDS_BARRIER();
}
__device__ __forceinline__ void wconv_tile(const float* W, int N, int k0, int n0, bf16_t* Bt, int Kd, int mode, LAS unsigned char* lds) {
    LAS float* tile = (LAS float*)lds;
    const int tid = threadIdx.x, col = tid & 255, rh = tid >> 8;
    float v[32];
    const bool ok = (n0 + col) < N;
    const float* src = W + (size_t)(k0 + rh) * N + n0 + col;
#pragma unroll
    for (int i = 0; i < 32; ++i) v[i] = ok ? __builtin_nontemporal_load(src + (size_t)(2 * i) * N) : 0.f;
#pragma unroll
    for (int i = 0; i < 32; ++i) tile[(2 * i + rh) * 257 + col] = v[i];
    LDS_BARRIER();
#pragma unroll
    for (int i = 0; i < 4; ++i) {
        const int o = tid + 512 * i, kg = o & 7, n = o >> 3;
        float f[8];
#pragma unroll
        for (int j = 0; j < 8; ++j) f[j] = tile[(8 * kg + j) * 257 + n];
        u32x4 w; w.x = cvt_pk_bf16(f[0], f[1]); w.y = cvt_pk_bf16(f[2], f[3]); w.z = cvt_pk_bf16(f[4], f[5]); w.w = cvt_pk_bf16(f[6], f[7]);
        const int nc = n0 + n;
        const int R = (mode == 0) ? nc : (256 * (nc >> 7) + (nc & 127) + (mode == 2 ? 128 : 0));
        *(u32x4*)(Bt + (size_t)R * Kd + k0 + 8 * kg) = w;
    }
    LDS_BARRIER();
}
constexpr int NT_FFN = 3 * 704, NT_WIN = 800, NT_WOUT = 256;
__device__ __forceinline__ void wconv_ffn_item(const Params& P, LAS unsigned char* lds, int i, const float* wg, const float* wu, const float* wd) {
    bf16_t* WUP = (bf16_t*)(P.ws + WS_WUP); bf16_t* WDN = (bf16_t*)(P.ws + WS_WDN);
    if (i < 704) wconv_tile(wg, DFF, (i / 22) * 64, (i % 22) * 256, WUP, DM, 1, lds);
    else if (i < 1408) { i -= 704; wconv_tile(wu, DFF, (i / 22) * 64, (i % 22) * 256, WUP, DM, 2, lds); }
    else { i -= 1408; wconv_tile(wd, DM, (i / 8) * 64, (i % 8) * 256, WDN, DFF, 0, lds); }
}
__device__ __forceinline__ void phase0(const Params& P, LAS unsigned char* lds) {
    constexpr int N_GEMV = 72 * KS_ADA;
    constexpr int NITEMS = N_GEMV + NT_FFN + NT_WIN + NT_WOUT;
    for (int it = blockIdx.x; it < NITEMS; it += gridDim.x) {
        int i = it;
        if (i < N_GEMV) { gemv_item(P, lds, i); continue; } i -= N_GEMV;
        if (i < NT_FFN) { wconv_ffn_item(P, lds, i, P.ffn1_wg, P.ffn1_wu, P.ffn1_wd); continue; } i -= NT_FFN;
        if (i < NT_WIN) { wconv_tile(P.w_in, NIN_REAL, (i / 25) * 64, (i % 25) * 256, (bf16_t*)(P.ws + WS_WIN), DM, 0, lds); continue; } i -= NT_WIN;
        wconv_tile(P.w_out, DM, (i / 8) * 64, (i % 8) * 256, (bf16_t*)(P.ws + WS_WOUT), DM, 0, lds);
    }
}

template <bool IN_BF16> __device__ __forceinline__ void norm_mod_phase(const Params& P, LAS unsigned char* lds, const void* xin_, const float* normw, int idx, bool from_partials, bf16_t* hout) {
    LAS float* As = (LAS float*)lds; LAS float* Bs = As + DM;
    const int tid = threadIdx.x, lane = tid & 63, wid = tid >> 6;
    const float* modp = (const float*)(P.ws + WS_MODP); const float* mods = (const float*)(P.ws + WS_MODS);
    for (int rb = blockIdx.x; rb < T_TOK / 64; rb += gridDim.x) {
        const int b = rb >> 6;
        __syncthreads();
        for (int k = tid; k < DM; k += 512) {
            float sh, sc;
            if (from_partials) {
                sh = P.b_ada[idx * DM + k]; sc = P.b_ada[(idx + 1) * DM + k];
#pragma unroll
                for (int s = 0; s < KS_ADA; ++s) { sh += modp[((size_t)s * NB + b) * NMOD + idx * DM + k]; sc += modp[((size_t)s * NB + b) * NMOD + (idx + 1) * DM + k]; }
            } else { sh = mods[(size_t)b * NMOD + idx * DM + k]; sc = mods[(size_t)b * NMOD + (idx + 1) * DM + k]; }
            As[k] = normw[k] * (1.f + sc); Bs[k] = sh;
        }
        __syncthreads();
        for (int rr = wid; rr < 64; rr += 16) {
            const int row0 = rb * 64 + rr, row1 = row0 + 8;
            f32x4 v0[8], v1[8]; float ss0 = 0.f, ss1 = 0.f;
            if (IN_BF16) {
                const u32x2* xr0 = (const u32x2*)((const bf16_t*)xin_ + (size_t)row0 * DM) + lane; const u32x2* xr1 = (const u32x2*)((const bf16_t*)xin_ + (size_t)row1 * DM) + lane;
                u32x2 r0[8], r1[8];
#pragma unroll
                for (int i = 0; i < 8; ++i) { r0[i] = xr0[64 * i]; r1[i] = xr1[64 * i]; }
#pragma unroll
                for (int i = 0; i < 8; ++i) { v0[i] = (f32x4){bf_lo(r0[i].x), bf_hi(r0[i].x), bf_lo(r0[i].y), bf_hi(r0[i].y)}; v1[i] = (f32x4){bf_lo(r1[i].x), bf_hi(r1[i].x), bf_lo(r1[i].y), bf_hi(r1[i].y)}; }
            } else {
                const f32x4* xr0 = (const f32x4*)((const float*)xin_ + (size_t)row0 * DM) + lane; const f32x4* xr1 = (const f32x4*)((const float*)xin_ + (size_t)row1 * DM) + lane;
#pragma unroll
                for (int i = 0; i < 8; ++i) { v0[i] = xr0[64 * i]; v1[i] = xr1[64 * i]; }
            }
#pragma unroll
            for (int i = 0; i < 8; ++i) { ss0 += (v0[i].x * v0[i].x + v0[i].y * v0[i].y) + (v0[i].z * v0[i].z + v0[i].w * v0[i].w);
                                          ss1 += (v1[i].x * v1[i].x + v1[i].y * v1[i].y) + (v1[i].z * v1[i].z + v1[i].w * v1[i].w); }
#pragma unroll
            for (int o = 1; o < 64; o <<= 1) { const float t0 = __shfl_xor(ss0, o), t1 = __shfl_xor(ss1, o); ss0 += t0; ss1 += t1; }
            const float rstd0 = 1.f / sqrtf(ss0 * (1.f / DM) + 1e-6f), rstd1 = 1.f / sqrtf(ss1 * (1.f / DM) + 1e-6f);
            u32x2* o80 = (u32x2*)(hout + (size_t)row0 * DM) + lane; u32x2* o81 = (u32x2*)(hout + (size_t)row1 * DM) + lane;
#pragma unroll
            for (int i = 0; i < 8; ++i) { const int k = (lane + 64 * i) * 4;
                const f32x4 a = *(const LAS f32x4*)(As + k), bb = *(const LAS f32x4*)(Bs + k);
                const f32x4 p0 = v0[i] * rstd0 * a + bb, p1 = v1[i] * rstd1 * a + bb;
                u32x2 w; w.x = cvt_pk_bf16(p0.x, p0.y); w.y = cvt_pk_bf16(p0.z, p0.w); o80[64 * i] = w;
                w.x = cvt_pk_bf16(p1.x, p1.y); w.y = cvt_pk_bf16(p1.z, p1.w); o81[64 * i] = w; }
        }
    }
}
__device__ __forceinline__ void mods_finalize(const Params& P) {
    const float* modp = (const float*)(P.ws + WS_MODP); float* mods = (float*)(P.ws + WS_MODS);
    for (int i = blockIdx.x * 512 + threadIdx.x; i < NB * NMOD; i += gridDim.x * 512) {
        const int b = i / NMOD, col = i % NMOD; float s = P.b_ada[col];
#pragma unroll
        for (int ks = 0; ks < KS_ADA; ++ks) s += modp[((size_t)ks * NB + b) * NMOD + col];
        mods[i] = s;
    }
}

__device__ __forceinline__ void gate_cols_phase(const Params& P, LAS unsigned char* lds) {
    const bf16_t* Hh = (const bf16_t*)(P.ws + WS_H); const bf16_t* WINp = (const bf16_t*)(P.ws + WS_WIN); bf16_t* PB = (bf16_t*)(P.ws + WS_BIG);
    const int tid = threadIdx.x, lane = tid & 63, wid = tid >> 6, fr = lane & 15, fq = lane >> 4, mt = wid & 3, kh = wid >> 2;
    LAS f32x4* part = (LAS f32x4*)lds;
    for (int rb = blockIdx.x; rb < T_TOK / 64; rb += gridDim.x) {
        const bf16_t* ap = Hh + (size_t)(rb * 64 + 16 * mt + fr) * DM + kh * 1024 + 8 * fq;
        const bf16_t* bp = WINp + (size_t)(6144 + fr) * DM + kh * 1024 + 8 * fq;
        f32x4 acc = (f32x4){0.f, 0.f, 0.f, 0.f};
#pragma unroll 1
        for (int k0 = 0; k0 < 32; k0 += 8) {
            bf16x8 a[8], b[8];
#pragma unroll
            for (int i = 0; i < 8; ++i) { a[i] = *(const bf16x8*)(ap + (k0 + i) * 32); b[i] = *(const bf16x8*)(bp + (k0 + i) * 32); }
#pragma unroll
            for (int i = 0; i < 8; ++i) acc = __builtin_amdgcn_mfma_f32_16x16x32_bf16(a[i], b[i], acc, 0, 0, 0);
        }
        LDS_BARRIER();
        if (kh == 1) part[mt * 64 + lane] = acc;
        LDS_BARRIER();
        if (kh == 0) {
            acc += part[mt * 64 + lane];
            bf16_t* op = PB + (size_t)(rb * 64 + 16 * mt + 4 * fq) * NIN + 6144 + fr;
#pragma unroll
            for (int j = 0; j < 4; ++j) op[(size_t)j * NIN] = (bf16_t)(cvt_pk_bf16(acc[j], 0.f) & 0xffffu);
        }
    }
}

__device__ __forceinline__ void conv_item(const Params& P, LAS unsigned char* lds, int item) {
    const bf16_t* PB = (const bf16_t*)(P.ws + WS_BIG); bf16_t* Y = (bf16_t*)(P.ws + WS_H);
    const int tid = threadIdx.x;
    const int b = item >> 7, t0 = (item & 127) * 32, ch = tid * 2;
    LAS unsigned* hs = (LAS unsigned*)lds + tid;
    LAS float* ps = (LAS float*)lds;
    LAS float* stat = (LAS float*)(lds + 131072);
    const bf16_t* colp = PB + (size_t)b * SEQ * NIN + ch;
#pragma unroll 1
    for (int j0 = 0; j0 < 64; j0 += 32) {
        unsigned ra[32], rg[32];
#pragma unroll
        for (int jj = 0; jj < 32; ++jj) { const int j = j0 + jj, tt = t0 - 30 + j, tc = tt < 0 ? 0 : (j < 62 ? tt : t0);
            const bf16_t* rp = colp + (size_t)tc * NIN; ra[jj] = *(const unsigned*)rp; rg[jj] = *(const unsigned*)(rp + 1024); }
        __builtin_amdgcn_sched_barrier(0);
#pragma unroll
        for (int jj = 0; jj < 32; ++jj) { const int j = j0 + jj, tt = t0 - 30 + j;
            float h0 = bf_lo(ra[jj]) * fast_sigmoid(bf_lo(rg[jj])), h1 = bf_hi(ra[jj]) * fast_sigmoid(bf_hi(rg[jj]));
            const bool ok = (tt >= 0) && (j < 62);
            h0 = ok ? h0 : 0.f; h1 = ok ? h1 : 0.f;
            if (j < 63) hs[j * 512] = cvt_pk_bf16(h0, h1); }
    }
    float acc0[32], acc1[32];
#pragma unroll
    for (int i = 0; i < 32; ++i) { acc0[i] = 0.f; acc1[i] = 0.f; }
#pragma unroll 1
    for (int g = 0; g < 8; ++g) {
        f32x2 w[4];
#pragma unroll
        for (int t = 0; t < 4; ++t) { const int tap = 4 * g + t; w[t] = *(const f32x2*)(P.w_dw + (tap < 31 ? tap : 30) * 1024 + ch); if (tap >= 31) w[t] = (f32x2){0.f, 0.f}; }
        const LAS unsigned* hp = hs + g * 4 * 512;
        float hl[35], hh[35];
#pragma unroll
        for (int r = 0; r < 35; ++r) { const unsigned hv = hp[r * 512]; hl[r] = bf_lo(hv); hh[r] = bf_hi(hv); }
#pragma unroll
        for (int i = 0; i < 32; ++i)
#pragma unroll
            for (int t = 0; t < 4; ++t) { acc0[i] += w[t].x * hl[i + t]; acc1[i] += w[t].y * hh[i + t]; }
    }
    const f32x2 bd = *(const f32x2*)(P.b_dw + ch);
    LDS_BARRIER();
#pragma unroll
    for (int i = 0; i < 32; ++i) {
        acc0[i] += bd.x; acc1[i] += bd.y;
        ps[i * 512 + tid] = acc0[i] + acc1[i];
        ps[16384 + i * 512 + tid] = acc0[i] * acc0[i] + acc1[i] * acc1[i];
    }
    LDS_BARRIER();
    {
        const int tok = tid >> 4, part = tid & 15;
        float s = 0.f, q = 0.f;
#pragma unroll
        for (int k = 0; k < 8; ++k) { const int off = tok * 512 + part * 32 + ((k + part) & 7) * 4;
            const f32x4 a = *(const LAS f32x4*)(ps + off), c = *(const LAS f32x4*)(ps + 16384 + off);
            s += (a[0] + a[1]) + (a[2] + a[3]); q += (c[0] + c[1]) + (c[2] + c[3]); }
#pragma unroll
        for (int o = 1; o < 16; o <<= 1) { s += __shfl_xor(s, o); q += __shfl_xor(q, o); }
        if (part == 0) { const float mu = s * (1.f / 1024.f), var = fmaxf(q * (1.f / 1024.f) - mu * mu, 0.f);
            stat[tok * 2] = mu; stat[tok * 2 + 1] = 1.f / sqrtf(var + 1e-6f); }
    }
    LDS_BARRIER();
    const f32x2 lw = *(const f32x2*)(P.conv_ln_w + ch), lb = *(const f32x2*)(P.conv_ln_b + ch);
    bf16_t* yp = Y + (size_t)(b * SEQ + t0) * DM + ch;
#pragma unroll
    for (int i = 0; i < 32; ++i) {
        const float mu = stat[i * 2], rstd = stat[i * 2 + 1];
        const float y0 = (acc0[i] - mu) * rstd * lw.x + lb.x, y1 = (acc1[i] - mu) * rstd * lw.y + lb.y;
        *(unsigned*)(yp + (size_t)i * DM) = cvt_pk_bf16(fast_silu(y0), fast_silu(y1));
    }
    LDS_BARRIER();
}

constexpr int PL_KH = 0, PL_QH = 17408, PL_RHS = 34816, PL_LM = 100352, PL_G = 117760, PL_BETA = 118016, PL_END = 118272;
constexpr int KH_STRIDE = 272;
constexpr int LM_STRIDE = 68;

__device__ __forceinline__ void dn_gate_load(const Params& P, int ch, float& gb, float& ga) {
    const bf16_t* PB = (const bf16_t*)(P.ws + WS_BIG);
    const int bh = ch >> 6, n = ch & 63, b = bh >> 3, h = bh & 7;
    const bf16_t* rp = PB + ((size_t)b * SEQ + n * 64 + (threadIdx.x & 63)) * NIN + 6144 + h;
    gb = bf1(rp[0]); ga = bf1(rp[8]);
}
__device__ __forceinline__ void dn_prep_chunk(const Params& P, LAS unsigned char* lds, int ch, float& gb, float& ga, int ch_next) {
    const bf16_t* PB = (const bf16_t*)(P.ws + WS_BIG);
    unsigned char* ops = P.ws + WS_SCAN + (size_t)ch * OPS_BYTES;
    const int tid = threadIdx.x, lane = tid & 63, wid = tid >> 6;
    const int bh = ch >> 6, n = ch & 63, b = bh >> 3, h = bh & 7;
    const size_t tok0 = (size_t)b * SEQ + n * 64;
    LAS float* Gs = (LAS float*)(lds + PL_G); LAS float* Bes = (LAS float*)(lds + PL_BETA);
    LAS float* RHS = (LAS float*)(lds + PL_RHS); LAS float* LM = (LAS float*)(lds + PL_LM);
    const int r0 = 4 * (tid >> 5), d4 = 4 * (tid & 31);
    u32x2 raw[3][7];
#pragma unroll
    for (int X = 0; X < 3; ++X)
#pragma unroll
        for (int j = 0; j < 7; ++j) {
            const int tl = n * 64 + r0 - 3 + j, tlc = tl < 0 ? 0 : tl;
            const u32x2 v = *(const u32x2*)(PB + ((size_t)b * SEQ + tlc) * NIN + 2048 + 1024 * X + h * 128 + d4);
            raw[X][j].x = tl >= 0 ? v.x : 0u; raw[X][j].y = tl >= 0 ? v.y : 0u;
        }
    if (wid == 0) {
        const float braw = gb, araw = ga;
        if (ch_next >= 0) dn_gate_load(P, ch_next, gb, ga);
        const float beta = 1.f / (1.f + __expf(-braw));
        const float xx = araw + P.dt_bias[h];
        const float sp = (xx > 20.f) ? xx : log1pf(__expf(xx));
        float g = -__expf(P.a_log[h]) * sp;
#pragma unroll
        for (int o = 1; o < 64; o <<= 1) { const float t = __shfl_up(g, o); if (lane >= o) g += t; }
        Gs[lane] = g; Bes[lane] = beta;
        if (lane == 63) ((float*)(P.ws + WS_GL))[ch] = __expf(g);
    }
    LDS_BARRIER();
    {
        const float Glast = Gs[63];
        float Gr[4], ber[4];
#pragma unroll
        for (int i = 0; i < 4; ++i) { Gr[i] = Gs[r0 + i]; ber[i] = Bes[r0 + i]; }
        float val[3][4][4];
#pragma unroll
        for (int X = 0; X < 3; ++X) {
            const int chX = 1024 * X + h * 128 + d4;
            f32x4 wt[4];
#pragma unroll
            for (int j = 0; j < 4; ++j) wt[j] = *(const f32x4*)(P.w_short + j * 3072 + chX);
            f32x4 xin[7];
#pragma unroll
            for (int j = 0; j < 7; ++j) xin[j] = (f32x4){bf_lo(raw[X][j].x), bf_hi(raw[X][j].x), bf_lo(raw[X][j].y), bf_hi(raw[X][j].y)};
#pragma unroll
            for (int i = 0; i < 4; ++i) {
                f32x4 s = wt[0] * xin[i] + wt[1] * xin[i + 1] + wt[2] * xin[i + 2] + wt[3] * xin[i + 3];
#pragma unroll
                for (int e = 0; e < 4; ++e) val[X][i][e] = fast_silu(s[e]);
            }
        }
        {
            float ss[8];
#pragma unroll
            for (int v = 0; v < 8; ++v) { const int X = v >> 2, i = v & 3;
                ss[v] = (val[X][i][0] * val[X][i][0] + val[X][i][1] * val[X][i][1]) + (val[X][i][2] * val[X][i][2] + val[X][i][3] * val[X][i][3]); }
#pragma unroll
            for (int o = 1; o < 32; o <<= 1) {
                float t[8];
#pragma unroll
                for (int v = 0; v < 8; ++v) t[v] = __shfl_xor(ss[v], o);
#pragma unroll
                for (int v = 0; v < 8; ++v) ss[v] += t[v];
            }
#pragma unroll
            for (int v = 0; v < 8; ++v) { const int X = v >> 2, i = v & 3;
                const float sc = __builtin_amdgcn_rsqf(ss[v] + 1e-6f) * (X == 0 ? 0.08838834764831845f : 1.f);
#pragma unroll
                for (int e = 0; e < 4; ++e) val[X][i][e] *= sc; }
        }
        const int kb = d4 >> 5, hi = (d4 >> 4) & 1, fqd = (d4 >> 2) & 3;
#pragma unroll
        for (int i = 0; i < 4; ++i) {
            const int r = r0 + i;
            u32x2 w;
            w.x = cvt_pk_bf16(val[1][i][0], val[1][i][1]); w.y = cvt_pk_bf16(val[1][i][2], val[1][i][3]);
            *(LAS u32x2*)(lds + PL_KH + r * KH_STRIDE + d4 * 2) = w;
            w.x = cvt_pk_bf16(val[0][i][0], val[0][i][1]); w.y = cvt_pk_bf16(val[0][i][2], val[0][i][3]);
            *(LAS u32x2*)(lds + PL_QH + r * KH_STRIDE + d4 * 2) = w;
            const float be = ber[i], beg = be * __expf(Gr[i]);
            *(LAS f32x4*)(RHS + r * 256 + d4) = (f32x4){val[2][i][0] * be, val[2][i][1] * be, val[2][i][2] * be, val[2][i][3] * be};
            *(LAS f32x4*)(RHS + r * 256 + 128 + d4) = (f32x4){val[1][i][0] * beg, val[1][i][1] * beg, val[1][i][2] * beg, val[1][i][3] * beg};
            const float eg = __expf(Gr[i]);
            w.x = cvt_pk_bf16(val[0][i][0] * eg, val[0][i][1] * eg); w.y = cvt_pk_bf16(val[0][i][2] * eg, val[0][i][3] * eg);
            const int mt = r >> 4, fr = r & 15;
            *(u32x2*)(ops + OPS_Q + ((mt * 4 + kb) * 64 + fqd * 16 + fr) * 16 + hi * 8) = w;
        }
        float ek[4];
#pragma unroll
        for (int i = 0; i < 4; ++i) ek[i] = __expf(Glast - Gr[i]);
        const int kb2 = r0 >> 5, hi2 = (r0 >> 4) & 1, fq2 = (r0 >> 2) & 3;
#pragma unroll
        for (int e = 0; e < 4; ++e) {
            const int d = d4 + e, dt = d >> 4, fr2 = d & 15;
            u32x2 w; w.x = cvt_pk_bf16(val[1][0][e] * ek[0], val[1][1][e] * ek[1]); w.y = cvt_pk_bf16(val[1][2][e] * ek[2], val[1][3][e] * ek[3]);
            *(u32x2*)(ops + OPS_KT + ((dt * 2 + kb2) * 64 + fq2 * 16 + fr2) * 16 + hi2 * 8) = w;
        }
    }
    LDS_BARRIER();
    {
        const int fr = lane & 15, fq = lane >> 4;
        for (int job = wid; job < 26; job += 8) {
            int ct, st; bool isL;
            if (job < 10) { isL = true; int j = job; ct = 0; while (j > ct) { j -= ct + 1; ++ct; } st = j; }
            else { isL = false; const int j = job - 10; ct = j >> 2; st = j & 3; }
            if (isL) {
                f32x4 acc = (f32x4){0.f, 0.f, 0.f, 0.f};
                bf16x8 fa[4], fbb[4];
#pragma unroll
                for (int kb = 0; kb < 4; ++kb) { fa[kb] = *(const LAS bf16x8*)(lds + PL_KH + (16 * ct + fr) * KH_STRIDE + kb * 64 + fq * 16);
                    fbb[kb] = *(const LAS bf16x8*)(lds + PL_KH + (16 * st + fr) * KH_STRIDE + kb * 64 + fq * 16); }
                __builtin_amdgcn_sched_barrier(0);
#pragma unroll
                for (int kb = 0; kb < 4; ++kb) acc = __builtin_amdgcn_mfma_f32_16x16x32_bf16(fa[kb], fbb[kb], acc, 0, 0, 0);
                const int s = 16 * st + fr; const float Gsv = Gs[s];
#pragma unroll
                for (int j = 0; j < 4; ++j) { const int c = 16 * ct + 4 * fq + j;
                    const float v = (c > s) ? Bes[c] * acc[j] * __expf(Gs[c] - Gsv) : 0.f;
                    LM[c * LM_STRIDE + s] = v; }
            } else {
                u32x2 w; w.x = 0u; w.y = 0u;
                if (ct >= st) {
                    f32x4 acc = (f32x4){0.f, 0.f, 0.f, 0.f};
                    bf16x8 fa[4], fbb[4];
#pragma unroll
                    for (int kb = 0; kb < 4; ++kb) { fa[kb] = *(const LAS bf16x8*)(lds + PL_KH + (16 * st + fr) * KH_STRIDE + kb * 64 + fq * 16);
                        fbb[kb] = *(const LAS bf16x8*)(lds + PL_QH + (16 * ct + fr) * KH_STRIDE + kb * 64 + fq * 16); }
                    __builtin_amdgcn_sched_barrier(0);
#pragma unroll
                    for (int kb = 0; kb < 4; ++kb) acc = __builtin_amdgcn_mfma_f32_16x16x32_bf16(fa[kb], fbb[kb], acc, 0, 0, 0);
                    const int c = 16 * ct + fr; const float Gc = Gs[c];
                    float v[4];
#pragma unroll
                    for (int j = 0; j < 4; ++j) { const int s = 16 * st + 4 * fq + j; v[j] = (c >= s) ? acc[j] * __expf(Gc - Gs[s]) : 0.f; }
                    w.x = cvt_pk_bf16(v[0], v[1]); w.y = cvt_pk_bf16(v[2], v[3]);
                }
                *(u32x2*)(ops + OPS_A + ((ct * 2 + (st >> 1)) * 64 + fq * 16 + fr) * 16 + (st & 1) * 8) = w;
            }
        }
    }
    LDS_BARRIER();
    if (tid < 256) {
        LAS float* lmb = LM; asm volatile("" : "+v"(lmb));
        LAS float* rhb = RHS + tid;
        float sol[64];
        f32x4 lb[2][16];
        float rv[2];
        rv[0] = rhb[0];
#pragma unroll
        for (int c = 0; c < 64; ++c) {
            if (c + 1 < 64) {
                rv[(c + 1) & 1] = rhb[(c + 1) * 256];
#pragma unroll
                for (int s4 = 0; s4 < (c + 4) / 4; ++s4) lb[(c + 1) & 1][s4] = *(const LAS f32x4*)(lmb + (c + 1) * LM_STRIDE + 4 * s4);
            }
            float xq[4] = {rv[c & 1], 0.f, 0.f, 0.f};
#pragma unroll
            for (int s4 = 0; s4 < (c + 3) / 4; ++s4) {
                const f32x4 l = lb[c & 1][s4];
#pragma unroll
                for (int e = 0; e < 4; ++e) if (4 * s4 + e < c) xq[e] -= l[e] * sol[4 * s4 + e];
            }
            sol[c] = (xq[0] + xq[1]) + (xq[2] + xq[3]);
        }
#pragma unroll
        for (int c = 0; c < 64; ++c) rhb[c * 256] = sol[c];
    }
    LDS_BARRIER();
#pragma unroll
    for (int i = 0; i < 2; ++i) {
        const int item = tid + 512 * i, f = item >> 6, ln = item & 63, fr = ln & 15, fq = ln >> 4, mt = f >> 2, kb = f & 3;
        const int c = 16 * mt + fr, dk = 32 * kb + 4 * fq;
        const f32x4 a = *(const LAS f32x4*)(RHS + c * 256 + 128 + dk), bb = *(const LAS f32x4*)(RHS + c * 256 + 128 + dk + 16);
        u32x4 w; w.x = cvt_pk_bf16(-a.x, -a.y); w.y = cvt_pk_bf16(-a.z, -a.w); w.z = cvt_pk_bf16(-bb.x, -bb.y); w.w = cvt_pk_bf16(-bb.z, -bb.w);
        *(u32x4*)(ops + OPS_W + item * 16) = w;
    }
#pragma unroll
    for (int i = 0; i < 2; ++i) {
        const int item = tid + 512 * i, f = item >> 6, ln = item & 63, fr = ln & 15, fq = ln >> 4, ds = f >> 1, mp = f & 1;
        float v[8];
#pragma unroll
        for (int j = 0; j < 4; ++j) { v[j] = RHS[(32 * mp + 4 * fq + j) * 256 + 16 * ds + fr]; v[4 + j] = RHS[(32 * mp + 16 + 4 * fq + j) * 256 + 16 * ds + fr]; }
        u32x4 w; w.x = cvt_pk_bf16(v[0], v[1]); w.y = cvt_pk_bf16(v[2], v[3]); w.z = cvt_pk_bf16(v[4], v[5]); w.w = cvt_pk_bf16(v[6], v[7]);
        *(u32x4*)(ops + OPS_U + item * 16) = w;
    }
    LDS_BARRIER();
}

__device__ __forceinline__ void scan_issue(LAS unsigned char* buf, const unsigned char* ops, int lane) {
#pragma unroll
    for (int f = 0; f < 56; ++f)
        __builtin_amdgcn_global_load_lds((const unsigned*)(ops + f * 1024 + lane * 16), (LAS unsigned*)(buf + f * 1024), 16, 0, 0);
}
__device__ __forceinline__ bf16x8 pack8(const f32x4 a, const f32x4 b) {
    u32x4 w; w.x = cvt_pk_bf16(a[0], a[1]); w.y = cvt_pk_bf16(a[2], a[3]); w.z = cvt_pk_bf16(b[0], b[1]); w.w = cvt_pk_bf16(b[2], b[3]);
    return __builtin_bit_cast(bf16x8, w);
}
__device__ __forceinline__ void scan_chain(const Params& P, LAS unsigned char* lds, int chain) {
    const int lane = threadIdx.x & 63, fr = lane & 15, fq = lane >> 4;
    const int xcd = chain & 7, idx = chain >> 3, ds = idx & 7, bh = xcd + 8 * (idx >> 3), b = bh >> 3, h = bh & 7;
    const unsigned char* ops0 = P.ws + WS_SCAN + (size_t)(bh * 64) * OPS_BYTES;
    bf16_t* O = (bf16_t*)(P.ws + WS_O);
    LAS float* OT = (LAS float*)(lds + 2 * 57344);
    float glall = ((const float*)(P.ws + WS_GL))[bh * 64 + lane];
    f32x4 S[8]; bf16x8 Sb[4];
#pragma unroll
    for (int i = 0; i < 8; ++i) S[i] = (f32x4){0.f, 0.f, 0.f, 0.f};
#pragma unroll
    for (int i = 0; i < 4; ++i) Sb[i] = (bf16x8){0, 0, 0, 0, 0, 0, 0, 0};
    scan_issue(lds, ops0, lane);
    u32x4 Un[2];
    Un[0] = *(const u32x4*)(ops0 + OPS_U + ((ds * 2 + 0) * 64 + lane) * 16); Un[1] = *(const u32x4*)(ops0 + OPS_U + ((ds * 2 + 1) * 64 + lane) * 16);
    for (int n = 0; n < 64; ++n) {
        asm volatile("s_waitcnt vmcnt(0)" ::: "memory");
        __builtin_amdgcn_sched_barrier(0);
        asm volatile("" : "+v"(Un[0]), "+v"(Un[1]), "+v"(glall));
        const u32x4 U0 = Un[0], U1 = Un[1];
        const float egl = __builtin_bit_cast(float, __builtin_amdgcn_readlane(__builtin_bit_cast(int, glall), n));
        LAS unsigned char* buf = lds + (n & 1) * 57344;
        if (n + 1 < 64) {
            const unsigned char* opn = ops0 + (size_t)(n + 1) * OPS_BYTES;
            scan_issue(lds + ((n + 1) & 1) * 57344, opn, lane);
            Un[0] = *(const u32x4*)(opn + OPS_U + ((ds * 2 + 0) * 64 + lane) * 16); Un[1] = *(const u32x4*)(opn + OPS_U + ((ds * 2 + 1) * 64 + lane) * 16);
        }
        __builtin_amdgcn_sched_barrier(0);
#define SC_LD(dst, base, idx) dst = *(const LAS bf16x8*)(buf + (base) + ((idx) * 64 + lane) * 16)
#define SC_SB __builtin_amdgcn_sched_barrier(0)
        bf16x8 fa[8], fb[8];
        f32x4 vn[4], o[4];
        vn[0] = (f32x4){bf_lo(U0.x), bf_hi(U0.x), bf_lo(U0.y), bf_hi(U0.y)}; vn[1] = (f32x4){bf_lo(U0.z), bf_hi(U0.z), bf_lo(U0.w), bf_hi(U0.w)};
        vn[2] = (f32x4){bf_lo(U1.x), bf_hi(U1.x), bf_lo(U1.y), bf_hi(U1.y)}; vn[3] = (f32x4){bf_lo(U1.z), bf_hi(U1.z), bf_lo(U1.w), bf_hi(U1.w)};
#pragma unroll
        for (int mt = 0; mt < 4; ++mt) o[mt] = (f32x4){0.f, 0.f, 0.f, 0.f};
#pragma unroll
        for (int mt = 0; mt < 4; ++mt) { SC_LD(fa[mt * 2 + 0], OPS_W, mt * 4 + 0); SC_LD(fa[mt * 2 + 1], OPS_W, mt * 4 + 1); }
        SC_SB;
#pragma unroll
        for (int mt = 0; mt < 4; ++mt) { SC_LD(fb[mt * 2 + 0], OPS_W, mt * 4 + 2); SC_LD(fb[mt * 2 + 1], OPS_W, mt * 4 + 3); }
        SC_SB;
#pragma unroll
        for (int k = 0; k < 2; ++k)
#pragma unroll
            for (int mt = 0; mt < 4; ++mt) vn[mt] = __builtin_amdgcn_mfma_f32_16x16x32_bf16(fa[mt * 2 + k], Sb[k], vn[mt], 0, 0, 0);
        SC_SB;
#pragma unroll
        for (int mt = 0; mt < 4; ++mt) { SC_LD(fa[mt * 2 + 0], OPS_Q, mt * 4 + 0); SC_LD(fa[mt * 2 + 1], OPS_Q, mt * 4 + 1); }
        SC_SB;
#pragma unroll
        for (int k = 0; k < 2; ++k)
#pragma unroll
            for (int mt = 0; mt < 4; ++mt) vn[mt] = __builtin_amdgcn_mfma_f32_16x16x32_bf16(fb[mt * 2 + k], Sb[2 + k], vn[mt], 0, 0, 0);
        bf16x8 vb[2]; vb[0] = pack8(vn[0], vn[1]); vb[1] = pack8(vn[2], vn[3]);
        SC_SB;
#pragma unroll
        for (int mt = 0; mt < 4; ++mt) { SC_LD(fb[mt * 2 + 0], OPS_Q, mt * 4 + 2); SC_LD(fb[mt * 2 + 1], OPS_Q, mt * 4 + 3); }
        SC_SB;
#pragma unroll
        for (int k = 0; k < 2; ++k)
#pragma unroll
            for (int mt = 0; mt < 4; ++mt) o[mt] = __builtin_amdgcn_mfma_f32_16x16x32_bf16(fa[mt * 2 + k], Sb[k], o[mt], 0, 0, 0);
        SC_SB;
#pragma unroll
        for (int i = 0; i < 8; ++i) SC_LD(fa[i], OPS_A, i);
        SC_SB;
#pragma unroll
        for (int k = 0; k < 2; ++k)
#pragma unroll
            for (int mt = 0; mt < 4; ++mt) o[mt] = __builtin_amdgcn_mfma_f32_16x16x32_bf16(fb[mt * 2 + k], Sb[2 + k], o[mt], 0, 0, 0);
        SC_SB;
#pragma unroll
        for (int i = 0; i < 8; ++i) SC_LD(fb[i], OPS_KT, i);
        SC_SB;
#pragma unroll
        for (int k2 = 0; k2 < 2; ++k2)
#pragma unroll
            for (int mt = 0; mt < 4; ++mt) o[mt] = __builtin_amdgcn_mfma_f32_16x16x32_bf16(fa[mt * 2 + k2], vb[k2], o[mt], 0, 0, 0);
        SC_SB;
#pragma unroll
        for (int i = 0; i < 8; ++i) SC_LD(fa[i], OPS_KT, 8 + i);
        SC_SB;
        {
#pragma unroll
            for (int mt = 0; mt < 4; ++mt)
#pragma unroll
                for (int j = 0; j < 4; ++j) OT[(16 * mt + 4 * fq + j) * 20 + fr] = o[mt][j];
            bf16_t* op = O + ((size_t)b * SEQ + n * 64 + (lane >> 2)) * 1024 + h * 128 + ds * 16 + (lane & 3) * 4;
#pragma unroll
            for (int i = 0; i < 4; ++i) { const f32x4 v = *(const LAS f32x4*)(OT + (16 * i + (lane >> 2)) * 20 + (lane & 3) * 4);
                u32x2 w; w.x = cvt_pk_bf16(v[0], v[1]); w.y = cvt_pk_bf16(v[2], v[3]); *(u32x2*)(op + (size_t)(16 * i) * 1024) = w; }
        }
        SC_SB;
#pragma unroll
        for (int dt = 0; dt < 8; ++dt) S[dt] *= egl;
#pragma unroll
        for (int k2 = 0; k2 < 2; ++k2)
#pragma unroll
            for (int dt = 0; dt < 4; ++dt) S[dt] = __builtin_amdgcn_mfma_f32_16x16x32_bf16(fb[dt * 2 + k2], vb[k2], S[dt], 0, 0, 0);
        SC_SB;
#pragma unroll
        for (int k2 = 0; k2 < 2; ++k2)
#pragma unroll
            for (int dt = 0; dt < 4; ++dt) S[4 + dt] = __builtin_amdgcn_mfma_f32_16x16x32_bf16(fa[dt * 2 + k2], vb[k2], S[4 + dt], 0, 0, 0);
        SC_SB;
#undef SC_LD
#undef SC_SB
#pragma unroll
        for (int kb = 0; kb < 4; ++kb) Sb[kb] = pack8(S[2 * kb], S[2 * kb + 1]);
        __builtin_amdgcn_sched_barrier(0);
        asm volatile("s_waitcnt lgkmcnt(0)" ::: "memory");
    }
    asm volatile("s_waitcnt vmcnt(0)" ::: "memory");
}

struct WcItem { const float* src; bf16_t* dst; int N, Kd; };
constexpr int NWL_FFN = 3 * 5632;
constexpr int SC_CONV = 2 * 57344 + 5120;
constexpr int SC_CONV_WAVE = 8704;
__device__ __forceinline__ WcItem wc_item(const Params& P, int i, const float* wg, const float* wu, const float* wd) {
    bf16_t* WUP = (bf16_t*)(P.ws + WS_WUP); bf16_t* WDN = (bf16_t*)(P.ws + WS_WDN);
    WcItem it;
    if (i < 11264) { const int up = i >= 5632; if (up) i -= 5632; const int k0 = (i / 176) * 64, n0 = (i % 176) * 32;
        it.src = (up ? wu : wg) + (size_t)k0 * DFF + n0; it.N = DFF; it.Kd = DM; it.dst = WUP + (size_t)(256 * (n0 >> 7) + (n0 & 127) + (up ? 128 : 0)) * DM + k0; }
    else { i -= 11264; const int k0 = (i / 64) * 64, n0 = (i % 64) * 32; it.src = wd + (size_t)k0 * DM + n0; it.N = DM; it.Kd = DFF; it.dst = WDN + (size_t)n0 * DFF + k0; }
    return it;
}
__device__ __forceinline__ void wc_load(const WcItem& it, f32x4 (&v)[8], int lane) {
    const int r = lane >> 3, c4 = (lane & 7) * 4;
#pragma unroll
    for (int i = 0; i < 8; ++i) v[i] = __builtin_nontemporal_load((const f32x4*)(it.src + (size_t)(8 * i + r) * it.N + c4));
}
__device__ __forceinline__ void wc_store(const WcItem& it, const f32x4 (&v)[8], LAS float* scr, int lane) {
    const int r = lane >> 3, c4 = (lane & 7) * 4;
#pragma unroll
    for (int i = 0; i < 8; ++i) { LAS float* d = scr + (8 * i + r) * 34 + c4; *(LAS f32x2*)d = (f32x2){v[i][0], v[i][1]}; *(LAS f32x2*)(d + 2) = (f32x2){v[i][2], v[i][3]}; }
    asm volatile("s_waitcnt lgkmcnt(0)" ::: "memory");
#pragma unroll
    for (int j = 0; j < 4; ++j) {
        const int o = lane + 64 * j, kg = o & 7, n = o >> 3;
        float f[8];
#pragma unroll
        for (int t = 0; t < 8; ++t) f[t] = scr[(8 * kg + t) * 34 + n];
        u32x4 w; w.x = cvt_pk_bf16(f[0], f[1]); w.y = cvt_pk_bf16(f[2], f[3]); w.z = cvt_pk_bf16(f[4], f[5]); w.w = cvt_pk_bf16(f[6], f[7]);
        *(u32x4*)(it.dst + (size_t)n * it.Kd + 8 * kg) = w;
    }
    asm volatile("s_waitcnt lgkmcnt(0)" ::: "memory");
}
__device__ __forceinline__ void wc_wave_loop(const Params& P, const float* wg, const float* wu, const float* wd, LAS float* scr, int gw, int NW, int lane) {
    int i0 = gw;
    if (i0 >= NWL_FFN) return;
    WcItem A = wc_item(P, i0, wg, wu, wd), B = A; bool hasB = (i0 + NW) < NWL_FFN;
    if (hasB) B = wc_item(P, i0 + NW, wg, wu, wd);
    f32x4 va[8], vb[8];
#pragma unroll
    for (int i = 0; i < 8; ++i) vb[i] = (f32x4){0.f, 0.f, 0.f, 0.f};
    wc_load(A, va, lane); if (hasB) wc_load(B, vb, lane);
    for (;;) {
        const WcItem cA = A, cB = B; const bool cHasB = hasB;
        f32x4 ca[8], cb[8];
#pragma unroll
        for (int i = 0; i < 8; ++i) { ca[i] = va[i]; cb[i] = vb[i]; }
        i0 += 2 * NW;
        const bool more = i0 < NWL_FFN;
        if (more) { A = wc_item(P, i0, wg, wu, wd); hasB = (i0 + NW) < NWL_FFN; if (hasB) B = wc_item(P, i0 + NW, wg, wu, wd);
            wc_load(A, va, lane); if (hasB) wc_load(B, vb, lane); }
        wc_store(cA, ca, scr, lane);
        if (cHasB) wc_store(cB, cb, scr, lane);
        if (!more) break;
    }
}

__device__ __forceinline__ void dn_out_phase(const Params& P) {
    const bf16_t* O = (const bf16_t*)(P.ws + WS_O); const bf16_t* PB = (const bf16_t*)(P.ws + WS_BIG); bf16_t* Y = (bf16_t*)(P.ws + WS_H);
    const int lane = threadIdx.x & 63, wid = threadIdx.x >> 6;
    const int d0 = (lane & 7) * 16;
    float nw[16];
#pragma unroll
    for (int i = 0; i < 16; ++i) nw[i] = P.dn_norm_w[d0 + i];
    const int NW = gridDim.x * 8;
    for (int row0 = blockIdx.x * 8 + wid; row0 < T_TOK; row0 += 2 * NW) {
        f32x4 v[2][4]; u32x4 z[2][2];
#pragma unroll
        for (int r = 0; r < 2; ++r) { const int row = (row0 + r * NW < T_TOK) ? row0 + r * NW : row0;
            const u32x4* op = (const u32x4*)(O + (size_t)row * 1024 + lane * 16);
            const u32x4* zp = (const u32x4*)(PB + (size_t)row * NIN + 5120 + lane * 16);
            const u32x4 q0 = op[0], q1 = op[1];
            v[r][0] = (f32x4){bf_lo(q0.x), bf_hi(q0.x), bf_lo(q0.y), bf_hi(q0.y)}; v[r][1] = (f32x4){bf_lo(q0.z), bf_hi(q0.z), bf_lo(q0.w), bf_hi(q0.w)};
            v[r][2] = (f32x4){bf_lo(q1.x), bf_hi(q1.x), bf_lo(q1.y), bf_hi(q1.y)}; v[r][3] = (f32x4){bf_lo(q1.z), bf_hi(q1.z), bf_lo(q1.w), bf_hi(q1.w)};
            z[r][0] = zp[0]; z[r][1] = zp[1]; }
#pragma unroll
        for (int r = 0; r < 2; ++r) {
            const int row = row0 + r * NW;
            if (row < T_TOK) {
                float ss = 0.f;
#pragma unroll
                for (int i = 0; i < 4; ++i) ss += (v[r][i].x * v[r][i].x + v[r][i].y * v[r][i].y) + (v[r][i].z * v[r][i].z + v[r][i].w * v[r][i].w);
                ss += __shfl_xor(ss, 1); ss += __shfl_xor(ss, 2); ss += __shfl_xor(ss, 4);
                const float rstd = 1.f / sqrtf(ss * (1.f / 128.f) + 1e-6f);
                const unsigned zz[8] = {z[r][0].x, z[r][0].y, z[r][0].z, z[r][0].w, z[r][1].x, z[r][1].y, z[r][1].z, z[r][1].w};
                unsigned w[8];
#pragma unroll
                for (int i = 0; i < 8; ++i) {
                    const float a = v[r][i >> 1][(i & 1) * 2] * rstd * nw[2 * i] * fast_silu(bf_lo(zz[i]));
                    const float bq = v[r][i >> 1][(i & 1) * 2 + 1] * rstd * nw[2 * i + 1] * fast_silu(bf_hi(zz[i]));
                    w[i] = cvt_pk_bf16(a, bq);
                }
                u32x4* yp = (u32x4*)(Y + (size_t)row * DM + 1024 + lane * 16);
                yp[0] = (u32x4){w[0], w[1], w[2], w[3]}; yp[1] = (u32x4){w[4], w[5], w[6], w[7]};
            }
        }
    }
}

__device__ __forceinline__ void final_norm_phase(const Params& P) {
    const bf16_t* X3 = (const bf16_t*)(P.ws + WS_H);
    const int lane = threadIdx.x & 63, wid = threadIdx.x >> 6;
    const int NW = gridDim.x * 8;
    for (int row = blockIdx.x * 8 + wid; row < T_TOK; row += 2 * NW) {
        const int row1 = row + NW; const bool two = row1 < T_TOK;
        const u32x2* xr0 = (const u32x2*)(X3 + (size_t)row * DM) + lane; const u32x2* xr1 = (const u32x2*)(X3 + (size_t)(two ? row1 : row) * DM) + lane;
        u32x2 r0[8], r1[8];
#pragma unroll
        for (int i = 0; i < 8; ++i) { r0[i] = xr0[64 * i]; r1[i] = xr1[64 * i]; }
        f32x4 v0[8], v1[8]; float ss0 = 0.f, ss1 = 0.f;
#pragma unroll
        for (int i = 0; i < 8; ++i) { v0[i] = (f32x4){bf_lo(r0[i].x), bf_hi(r0[i].x), bf_lo(r0[i].y), bf_hi(r0[i].y)}; v1[i] = (f32x4){bf_lo(r1[i].x), bf_hi(r1[i].x), bf_lo(r1[i].y), bf_hi(r1[i].y)};
            ss0 += (v0[i].x * v0[i].x + v0[i].y * v0[i].y) + (v0[i].z * v0[i].z + v0[i].w * v0[i].w);
            ss1 += (v1[i].x * v1[i].x + v1[i].y * v1[i].y) + (v1[i].z * v1[i].z + v1[i].w * v1[i].w); }
#pragma unroll
        for (int o = 1; o < 64; o <<= 1) { const float t0 = __shfl_xor(ss0, o), t1 = __shfl_xor(ss1, o); ss0 += t0; ss1 += t1; }
        const float rstd0 = 1.f / sqrtf(ss0 * (1.f / DM) + 1e-6f), rstd1 = 1.f / sqrtf(ss1 * (1.f / DM) + 1e-6f);
        f32x4* o0 = (f32x4*)(P.out + (size_t)row * DM) + lane; f32x4* o1 = (f32x4*)(P.out + (size_t)(two ? row1 : row) * DM) + lane;
#pragma unroll
        for (int i = 0; i < 8; ++i) { const f32x4 w = *((const f32x4*)P.final_norm + lane + 64 * i); __builtin_nontemporal_store(v0[i] * rstd0 * w, o0 + 64 * i); if (two) __builtin_nontemporal_store(v1[i] * rstd1 * w, o1 + 64 * i); }
    }
}

#define XB_TMO      128
#define XB_XCNT(j)  (256  + 64 * (j))
#define XB_XSUB(j)  (1280 + 64 * (j))
#define XB_XGEN(j)  (2304 + 64 * (j))
#define XB_TOP      3328
#define XB_TOPGEN   3392
#define XCD_BAR_WORDS 3456
#define XB_SPIN_CAP (1u << 22)
__device__ __forceinline__ unsigned xb_ld(unsigned* p)              { return __hip_atomic_load(p, __ATOMIC_RELAXED, __HIP_MEMORY_SCOPE_AGENT); }
__device__ __forceinline__ unsigned xb_add(unsigned* p, unsigned v) { return __hip_atomic_fetch_add(p, v, __ATOMIC_RELAXED, __HIP_MEMORY_SCOPE_AGENT); }
__device__ __forceinline__ unsigned xb_xcc_id() { return (unsigned)__builtin_amdgcn_s_getreg((3 << 11) | 20) & 0xFu; }
#define XB_SPIN(cond, bar) do { unsigned _sp = 0; while (cond) { __builtin_amdgcn_s_sleep(1); \
    if ((++_sp & 255u) == 0u) { if (xb_ld(&(bar)[XB_TMO])) break; if (_sp > XB_SPIN_CAP) { atomicAdd(&(bar)[XB_TMO], 1u); break; } } } } while (0)
struct XcdBarrier { unsigned* bar; unsigned x; volatile LAS unsigned* st; };
__device__ __forceinline__ XcdBarrier xcd_barrier_post(unsigned* bar, volatile LAS unsigned* st) {
    XcdBarrier b; b.bar = bar; b.x = xb_xcc_id(); b.st = st;
    if (threadIdx.x == 0) (void)xb_add(&bar[XB_XCNT(b.x)], 1u);
    return b;
}
__device__ __forceinline__ void xcd_barrier_complete(unsigned* bar, unsigned x, unsigned& nloc, unsigned& nx) {
    const unsigned G = gridDim.x * gridDim.y * gridDim.z;
    unsigned sum, cnt, mine, sp = 0u;
    for (;;) {
        sum = 0u; cnt = 0u; mine = 0u;
#pragma unroll
        for (unsigned j = 0; j < 16; ++j) { const unsigned c = xb_ld(&bar[XB_XCNT(j)]); sum += c; cnt += (c > 0u) ? 1u : 0u; mine = (j == x) ? c : mine; }
        if (sum == G) break;
        __builtin_amdgcn_s_sleep(1);
        if ((++sp & 255u) == 0u) { if (xb_ld(&bar[XB_TMO])) break; if (sp > XB_SPIN_CAP) { atomicAdd(&bar[XB_TMO], 1u); break; } }
    }
    nloc = mine > 0u ? mine : 1u; nx = cnt > 0u ? cnt : 1u;
}
__device__ __forceinline__ void xcd_barrier(const XcdBarrier& b) {
    asm volatile("s_waitcnt vmcnt(0)" ::: "memory");
    __syncthreads();
    if (threadIdx.x == 0) {
        unsigned* bar = b.bar;
        __builtin_amdgcn_s_waitcnt(0);
        unsigned nloc = b.st[0], nx = b.st[1];
        if (nloc == 0u) { xcd_barrier_complete(bar, b.x, nloc, nx); b.st[0] = nloc; b.st[1] = nx; }
        const unsigned old = xb_add(&bar[XB_XSUB(b.x)], 1u);
        const unsigned gen = old / nloc;
        if (old + 1u == (gen + 1u) * nloc) {
            __builtin_amdgcn_fence(__ATOMIC_RELEASE, "agent");
            asm volatile("s_waitcnt vmcnt(0)" ::: "memory");
            const unsigned og = xb_add(&bar[XB_TOP], 1u);
            const unsigned tg = og / nx;
            if (og + 1u == (tg + 1u) * nx) xb_add(&bar[XB_TOPGEN], 1u);
            else XB_SPIN(xb_ld(&bar[XB_TOPGEN]) == tg, bar);
            __builtin_amdgcn_fence(__ATOMIC_ACQUIRE, "agent");
            xb_add(&bar[XB_XGEN(b.x)], 1u);
            asm volatile("s_waitcnt vmcnt(0)" ::: "memory");
        } else {
            XB_SPIN(xb_ld(&bar[XB_XGEN(b.x)]) == gen, bar);
            __builtin_amdgcn_fence(__ATOMIC_ACQUIRE, "agent");
            asm volatile("s_waitcnt vmcnt(0)" ::: "memory");
        }
    }
    __syncthreads();
}

constexpr int N_PHASES = 14;
#ifdef ONLY_PH
#define PH_ON(k) ((k) == ONLY_PH)
#else
#define PH_ON(k) 1
#endif
__global__ void __launch_bounds__(512, 2) fwd_megakernel(Params P) {
    extern __shared__ __attribute__((aligned(16))) unsigned char lds_raw[];
    LAS unsigned char* lds = (LAS unsigned char*)lds_raw;
    const int G = gridDim.x;
    bf16_t* H = (bf16_t*)(P.ws + WS_H); bf16_t* BIG = (bf16_t*)(P.ws + WS_BIG);
    bf16_t* XB = (bf16_t*)P.out;
    const bf16_t* WUP = (const bf16_t*)(P.ws + WS_WUP); const bf16_t* WDN = (const bf16_t*)(P.ws + WS_WDN);
    const bf16_t* WIN = (const bf16_t*)(P.ws + WS_WIN); const bf16_t* WOUT = (const bf16_t*)(P.ws + WS_WOUT);
    const float* mods = (const float*)(P.ws + WS_MODS);
    const int lo = P.ph_lo, hi = P.ph_hi;
    volatile LAS unsigned* xst = (volatile LAS unsigned*)(lds + LDS_BYTES - 16);
    XcdBarrier xbar; xbar.bar = (unsigned*)(P.ws + WS_BAR); xbar.x = 0; xbar.st = xst;
    if (hi - lo > 1) {
        if (threadIdx.x == 0) { xst[0] = 0u; xst[1] = 0u; }
        __syncthreads();
        xbar = xcd_barrier_post((unsigned*)(P.ws + WS_BAR), xst);
    }
    if (lo < 0) cg::this_grid().sync();
#define IN(k) (PH_ON(k) && lo <= (k) && (k) < hi)
#define SEAM(k) do { if (lo <= (k) && (k) + 1 < hi) { for (int _s = 0; _s < PROBE_SYNC_REP; ++_s) { xcd_barrier(xbar); } } } while (0)
#define REPN(k) for (int _r = 0; _r < (((PROBE_REP_MASK >> (k)) & 1) ? 2 : 1); ++_r)
    if (IN(0)) REPN(0) { phase0(P, lds); }
    SEAM(0);
    if (IN(1)) REPN(1) { mods_finalize(P); norm_mod_phase<false>(P, lds, P.x, P.ffn1_norm, 0, true, H); }
    SEAM(1);
    if (IN(2)) REPN(2) { pg8::Gemm g{H, WUP, T_TOK, NUP, DM}; pg8::StaticOrder S; S.init(T_TOK, NUP, G, blockIdx.x, 8); pg8::EpiSwiGLU E{BIG, DFF}; pg8::gemm_phase(lds, g, S, E); }
    SEAM(2);
    if (IN(3)) REPN(3) { pg8::Gemm g{BIG, WDN, T_TOK, DM, DFF}; pg8::StaticOrder S; S.init(T_TOK, DM, G, blockIdx.x); pg8::EpiResidB<false, true> E{P.x, XB, mods + 2 * DM}; pg8::gemm_phase(lds, g, S, E); }
    SEAM(3);
    if (IN(4)) REPN(4) { norm_mod_phase<true>(P, lds, XB, P.mix_norm, 3, false, H); }
    SEAM(4);
    if (IN(5)) REPN(5) { pg8::Gemm g{H, WIN, T_TOK, 6144, DM}; pg8::StaticOrder S; S.init(T_TOK, 6144, G, blockIdx.x); pg8::EpiBf16 E{BIG, NIN}; pg8::gemm_phase(lds, g, S, E); gate_cols_phase(P, lds); }
    SEAM(5);
    if (IN(6)) REPN(6) {
        for (int _p = 0; _p < PROBE_PREP_REP; ++_p) { float gb = 0.f, ga = 0.f; int ch = blockIdx.x;
            if (ch < NCH_TOT) dn_gate_load(P, ch, gb, ga);
            for (; ch < NCH_TOT; ch += G) dn_prep_chunk(P, lds, ch, gb, ga, (ch + G < NCH_TOT) ? ch + G : -1); }
        for (int _p = 0; _p < PROBE_CONV_REP; ++_p) for (int it = blockIdx.x; it < NB * (SEQ / 32); it += G) conv_item(P, lds, it);
    }
    SEAM(6);
    if (IN(7)) REPN(7) {
        const int wv = threadIdx.x >> 6;
        if (wv == 0) { for (int chain = blockIdx.x; chain < 256; chain += G) scan_chain(P, lds, chain); }
        else if (wv >= 3) {
            const int lane = threadIdx.x & 63, gw = blockIdx.x * 5 + (wv - 3), NW = G * 5;
            LAS float* scr = (LAS float*)(lds + SC_CONV + (wv - 3) * SC_CONV_WAVE);
            wc_wave_loop(P, P.ffn2_wg, P.ffn2_wu, P.ffn2_wd, scr, gw, NW, lane);
        }
    }
    SEAM(7);
    if (IN(8)) REPN(8) { dn_out_phase(P); }
    SEAM(8);
    if (IN(9)) { pg8::Gemm g{H, WOUT, T_TOK, DM, DM}; pg8::StaticOrder S; S.init(T_TOK, DM, G, blockIdx.x); pg8::EpiResidB<true, false> E{XB, XB, mods + 5 * DM}; pg8::gemm_phase(lds, g, S, E); }
    SEAM(9);
    if (IN(10)) REPN(10) { norm_mod_phase<true>(P, lds, XB, P.ffn2_norm, 6, false, H); }
    SEAM(10);
    if (IN(11)) REPN(11) { pg8::Gemm g{H, WUP, T_TOK, NUP, DM}; pg8::StaticOrder S; S.init(T_TOK, NUP, G, blockIdx.x, 8); pg8::EpiSwiGLU E{BIG, DFF}; pg8::gemm_phase(lds, g, S, E); }
    SEAM(11);
    if (IN(12)) { pg8::Gemm g{BIG, WDN, T_TOK, DM, DFF}; pg8::StaticOrder S; S.init(T_TOK, DM, G, blockIdx.x); pg8::EpiResidB<true, true> E{XB, H, mods + 8 * DM}; pg8::gemm_phase(lds, g, S, E); }
    SEAM(12);
    if (IN(13)) { final_norm_phase(P); }
#undef IN
#undef SEAM
}

extern "C" void kernel_launch(void* const* d_in, const int* in_sizes, int n_in, void* d_out, int out_size, void* d_ws, size_t ws_size, hipStream_t stream) {
    static int grid = 0;
    if (grid == 0) {
        if (n_in != 24 || out_size != T_TOK * DM || ws_size < WS_END) { fprintf(stderr, "kernel_launch: unexpected shapes (n_in %d out %d ws %zu need %zu)\n", n_in, out_size, ws_size, (size_t)WS_END); grid = -1; return; }
        int dev = 0, cus = 0, per_cu = 0;
        hipGetDevice(&dev); hipDeviceGetAttribute(&cus, hipDeviceAttributeMultiprocessorCount, dev);
        if (hipFuncSetAttribute((const void*)fwd_megakernel, hipFuncAttributeMaxDynamicSharedMemorySize, LDS_BYTES) != hipSuccess) { fprintf(stderr, "kernel_launch: hipFuncSetAttribute failed\n"); grid = -1; return; }
        hipOccupancyMaxActiveBlocksPerMultiprocessor(&per_cu, (const void*)fwd_megakernel, 512, LDS_BYTES);
        if (per_cu < 1) { fprintf(stderr, "kernel_launch: occupancy query says %d\n", per_cu); per_cu = 1; }
        (void)hipGetLastError();
        grid = cus;
    }
    if (grid < 0) return;
    Params p{};
    const float** pp = (const float**)&p;
    for (int i = 0; i < 24; ++i) pp[i] = (const float*)d_in[i];
    p.out = (float*)d_out; p.ws = (unsigned char*)d_ws;
    hipMemsetAsync(d_ws, 0, XCD_BAR_WORDS * 4, stream);
#if MK_MULTI
    for (int ph = 0; ph < N_PHASES; ++ph) { p.ph_lo = ph; p.ph_hi = ph + 1; hipLaunchKernelGGL(fwd_megakernel, dim3(grid), dim3(512), LDS_BYTES, stream, p); }
#else
    p.ph_lo = 0; p.ph_hi = N_PHASES;
    void* args[] = {&p};
    hipError_t e = hipLaunchCooperativeKernel((const void*)fwd_megakernel, dim3(grid), dim3(512), args, LDS_BYTES, stream);
    if (e != hipSuccess) fprintf(stderr, "cooperative launch failed: %s (grid %d)\n", hipGetErrorString(e), grid);
#endif
}
```
